# Optimizing an MI355X kernel written in HIP

```python
import math
import jax, jax.numpy as jnp
from jax import lax
import numpy as np

D_MODEL = 1024
BATCH = 8
SEQ = 4096
DEPTH = 4

GRID_W = 64
CTX_LEN = 256

A_HEADS = 8
A_KV_HEADS = 2
A_HEAD_DIM = 64
Q_BLOCK = 128
ROPE_THETA = 10000.0
B_HEADS = 8
B_HEAD_DIM = 64
NA_ROWS = 8
NA_COLS = 16
C_HEADS = 8
C_HEAD_DIM = 64
CONV_K = 4
CHUNK = 64
N_BRANCH = 3
BRANCH_W = 512
N_EXPERTS = 16
D_EXPERT = 2048
CAPACITY = 2
N_MOD = 6
LN_EPS = 1e-6
DEEPNORM_ALPHA = (2 * DEPTH) ** 0.25
DEEPNORM_BETA = (8 * DEPTH) ** -0.25

A_Q_W = A_HEADS * A_HEAD_DIM
A_KV_W = A_KV_HEADS * A_HEAD_DIM
B_W = B_HEADS * B_HEAD_DIM
C_W = C_HEADS * C_HEAD_DIM
IN_SIZES = (A_Q_W, A_KV_W, A_KV_W, B_W, B_W, B_W, 3 * C_W, C_W, 2 * C_HEADS, 2 * C_HEADS, N_BRANCH * D_MODEL)
D_IN = sum(IN_SIZES)

kernel_name = 'hybrid_diffusion_trunk'


def layer_norm(x):
    xf = x.astype(jnp.float32)
    mu = jnp.mean(xf, axis=-1, keepdims=True)
    var = jnp.mean(jnp.square(xf - mu), axis=-1, keepdims=True)
    return ((xf - mu) * lax.rsqrt(var + LN_EPS)).astype(x.dtype)


def layer_norm_affine(x, g, b):
    return layer_norm(x) * g + b


def rms_norm(x, g):
    xf = x.astype(jnp.float32)
    y = xf * lax.rsqrt(jnp.mean(jnp.square(xf), axis=-1, keepdims=True) + LN_EPS)
    return y.astype(x.dtype) * g


def l2_normalize(x):
    return x * lax.rsqrt(jnp.sum(jnp.square(x), axis=-1, keepdims=True) + LN_EPS)


def modulate(x, shift, scale):
    return x * (1 + scale) + shift


def softmax_f32(s):
    return jax.nn.softmax(s.astype(jnp.float32), axis=-1)


def split_in(z):
    return jnp.split(z, np.cumsum(IN_SIZES)[:-1].tolist(), axis=-1)


def heads(t, n_heads, head_dim):
    return t.reshape(t.shape[0], t.shape[1], n_heads, head_dim)


def rope_tables(n_tokens, dtype):
    t = jnp.arange(n_tokens)
    rows = (t // GRID_W).astype(jnp.float32)
    cols = (t % GRID_W).astype(jnp.float32)
    n_freq = A_HEAD_DIM // 4
    inv_freq = ROPE_THETA ** (-jnp.arange(n_freq, dtype=jnp.float32) / n_freq)
    ang_r = rows[:, None] * inv_freq
    ang_c = cols[:, None] * inv_freq
    return tuple(a.astype(dtype) for a in (jnp.cos(ang_r), jnp.sin(ang_r), jnp.cos(ang_c), jnp.sin(ang_c)))


def apply_rope_2d(x, tables):
    cr, sr, cc, sc = [t[None, :, None, :] for t in tables]
    x1, x2, x3, x4 = jnp.split(x, 4, axis=-1)
    return jnp.concatenate([x1 * cr - x2 * sr, x2 * cr + x1 * sr,
                            x3 * cc - x4 * sc, x4 * cc + x3 * sc], axis=-1)


def dense_attention(q, k, v):
    b, m, h, d = q.shape
    kvh = k.shape[2]
    qg = q.reshape(b, m, kvh, h // kvh, d)
    s = jnp.einsum('bqkgd,bmkd->bkgqm', qg, k) * (d ** -0.5)
    p = softmax_f32(s).astype(v.dtype)
    return jnp.einsum('bkgqm,bmkd->bqkgd', p, v).reshape(b, m, h * d)


def gqa_latent(q, k_all, v_all):
    b, n = q.shape[:2]
    g = A_HEADS // A_KV_HEADS
    nb = n // Q_BLOCK
    qb = q.reshape(b, nb, Q_BLOCK, A_KV_HEADS, g, A_HEAD_DIM).transpose(1, 0, 3, 4, 2, 5)
    scale = A_HEAD_DIM ** -0.5

    def block(qi):
        s = jnp.einsum('bkgqd,bkmd->bkgqm', qi, k_all) * scale
        p = softmax_f32(s).astype(v_all.dtype)
        return jnp.einsum('bkgqm,bkmd->bkgqd', p, v_all)

    o = lax.map(block, qb)
    return o.transpose(1, 0, 4, 2, 3, 5).reshape(b, n, A_HEADS * A_HEAD_DIM)


def neighborhood_latent(q, k, v, k_ctx, v_ctx, rpb):
    b, n = q.shape[:2]
    rows = n // GRID_W
    win_r = min(NA_ROWS, rows)

    def to_grid(t):
        return t.reshape(b, rows, GRID_W, B_HEADS, B_HEAD_DIM).transpose(0, 3, 1, 2, 4)

    qg, kg, vg = to_grid(q), to_grid(k), to_grid(v)
    kc = k_ctx.transpose(0, 2, 1, 3)
    vc = v_ctx.transpose(0, 2, 1, 3)
    cols = np.arange(GRID_W)
    col_start = np.clip(cols - NA_COLS // 2, 0, GRID_W - NA_COLS)
    col_idx = col_start[:, None] + np.arange(NA_COLS)[None, :]
    col_off = col_idx - cols[:, None] + (NA_COLS - 1)
    rpb_cols = rpb[:, :, col_off]
    scale = B_HEAD_DIM ** -0.5

    def row_block(r):
        rs = jnp.clip(r - win_r // 2, 0, rows - win_r)
        qr = lax.dynamic_index_in_dim(qg, r, axis=2, keepdims=False)
        k_rows = lax.dynamic_slice_in_dim(kg, rs, win_r, axis=2)
        v_rows = lax.dynamic_slice_in_dim(vg, rs, win_r, axis=2)
        k_nb = k_rows[:, :, :, col_idx]
        v_nb = v_rows[:, :, :, col_idx]
        row_off = rs + jnp.arange(win_r) - r + (NA_ROWS - 1)
        bias = jnp.take(rpb_cols, row_off, axis=1).transpose(0, 2, 1, 3)
        s_nb = jnp.einsum('bhqd,bhrqjd->bhqrj', qr, k_nb) * scale + bias[None]
        s_nb = s_nb.reshape(b, B_HEADS, GRID_W, win_r * NA_COLS)
        s_ctx = jnp.einsum('bhqd,bhmd->bhqm', qr, kc) * scale
        p = softmax_f32(jnp.concatenate([s_nb, s_ctx], axis=-1)).astype(v.dtype)
        p_nb = p[..., :win_r * NA_COLS].reshape(b, B_HEADS, GRID_W, win_r, NA_COLS)
        p_ctx = p[..., win_r * NA_COLS:]
        return (jnp.einsum('bhqrj,bhrqjd->bhqd', p_nb, v_nb)
                + jnp.einsum('bhqm,bhmd->bhqd', p_ctx, vc))

    o = lax.map(row_block, jnp.arange(rows))
    return o.transpose(1, 0, 3, 2, 4).reshape(b, n, B_HEADS * B_HEAD_DIM)


def short_conv(x, w):
    n = x.shape[1]
    left = CONV_K // 2
    xp = jnp.pad(x, ((0, 0), (left, CONV_K - 1 - left), (0, 0)))
    y = xp[:, 0:n] * w[0]
    for j in range(1, CONV_K):
        y = y + xp[:, j:j + n] * w[j]
    return jax.nn.silu(y)


def gdn_prepare(qkv, a, bt, a_log, dt_bias):
    b, n = qkv.shape[:2]
    q, k, v = jnp.split(qkv.astype(jnp.float32), 3, axis=-1)
    q = l2_normalize(heads(q, C_HEADS, C_HEAD_DIM)) * (C_HEAD_DIM ** -0.5)
    k = l2_normalize(heads(k, C_HEADS, C_HEAD_DIM))
    v = heads(v, C_HEADS, C_HEAD_DIM)
    a = a.astype(jnp.float32).reshape(b, n, 2, C_HEADS)
    bt = bt.astype(jnp.float32).reshape(b, n, 2, C_HEADS)
    g = -jnp.exp(a_log.astype(jnp.float32)) * jax.nn.softplus(a + dt_bias.astype(jnp.float32))
    beta = jax.nn.sigmoid(bt)

    def both(t):
        return jnp.stack([t, jnp.flip(t, axis=1)], axis=0).transpose(0, 1, 3, 2, 4)

    def both_dir(t):
        return jnp.stack([t[:, :, 0], jnp.flip(t[:, :, 1], axis=1)], axis=0).transpose(0, 1, 3, 2)

    return both(q), both(k), both(v), both_dir(g), both_dir(beta)


def gated_delta_rule(q, k, v, g, beta, s0, with_output):
    lead = q.shape[:-2]
    nd = len(lead)
    n = q.shape[-2]
    nc = n // CHUNK

    def chunks(t):
        return t.reshape(lead + (nc, CHUNK) + t.shape[nd + 1:])

    qc, kc, vc, gc, bc = chunks(q), chunks(k), chunks(v), chunks(g), chunks(beta)
    gcum = jnp.cumsum(gc, axis=-1)
    idx = jnp.arange(CHUNK)
    incl = idx[:, None] >= idx[None, :]
    strict = idx[:, None] > idx[None, :]
    decay = jnp.exp(jnp.where(incl, gcum[..., :, None] - gcum[..., None, :], -jnp.inf))
    kb = kc * bc[..., None]
    vb = vc * bc[..., None]
    lmat = jnp.where(strict, jnp.einsum('...id,...jd->...ij', kb, kc) * decay, 0.0)
    eye = jnp.eye(CHUNK, dtype=jnp.float32)
    tmat = lax.linalg.triangular_solve(eye + lmat, jnp.broadcast_to(eye, lmat.shape),
                                       left_side=True, lower=True, unit_diagonal=True)
    u = tmat @ vb
    w = tmat @ (kb * jnp.exp(gcum)[..., None])
    glast = gcum[..., -1:]
    kdec = kc * jnp.exp(glast - gcum)[..., None]
    sdec = jnp.exp(glast[..., 0])
    xs = (u, w, kdec, sdec)
    if with_output:
        qdec = qc * jnp.exp(gcum)[..., None]
        intra = jnp.where(incl, jnp.einsum('...id,...jd->...ij', qc, kc) * decay, 0.0)
        xs = xs + (qdec, intra)
    xs = tuple(jnp.moveaxis(t, nd, 0) for t in xs)

    def step(s, inp):
        u_i, w_i, kd_i, sd_i = inp[:4]
        v_new = u_i - w_i @ s
        s_next = s * sd_i[..., None, None] + jnp.swapaxes(kd_i, -1, -2) @ v_new
        if with_output:
            qd_i, intra_i = inp[4:]
            return s_next, qd_i @ s + intra_i @ v_new
        return s_next, None

    s_fin, o = lax.scan(step, s0, xs)
    if not with_output:
        return None, s_fin
    o = jnp.moveaxis(o, 0, nd).reshape(lead + (n, v.shape[-1]))
    return o, s_fin


def gdn_branch(qkv, a, bt, gate, a_log, dt_bias, o_gain, s0, with_output):
    b, n = qkv.shape[:2]
    q2, k2, v2, g2, beta2 = gdn_prepare(qkv, a, bt, a_log, dt_bias)
    o2, s_fin = gated_delta_rule(q2, k2, v2, g2, beta2, s0, with_output)
    if not with_output:
        return None, s_fin
    o = (o2[0] + jnp.flip(o2[1], axis=-2)).transpose(0, 2, 1, 3)
    o = rms_norm(o, o_gain) * jax.nn.silu(heads(gate.astype(jnp.float32), C_HEADS, C_HEAD_DIM))
    return o.reshape(b, n, C_W).astype(qkv.dtype), s_fin


def merge_branches(branches, gate_logits, w_branch, w_out):
    b, n = gate_logits.shape[:2]
    gates = jax.nn.sigmoid(gate_logits.astype(jnp.float32)).astype(gate_logits.dtype)
    gates = gates.reshape(b, n, N_BRANCH, D_MODEL)
    m = gates[:, :, 0] * (branches[0] @ w_branch[0])
    for i in range(1, N_BRANCH):
        m = m + gates[:, :, i] * (branches[i] @ w_branch[i])
    return m @ w_out


def token_mixers(h, h_x, rope, w_in, qk_gain, rpb, conv_w, a_log, dt_bias, o_gain, w_branch, w_out, need_ctx):
    b = h.shape[0]
    qa, ka, va, qb, kb, vb, qkv_c, gate_c, a_c, b_c, mg = split_in(h @ w_in)
    qa_x, ka_x, va_x, qb_x, kb_x, vb_x, qkv_cx, gate_cx, a_cx, b_cx, mg_x = split_in(h_x @ w_in)
    qa = apply_rope_2d(rms_norm(heads(qa, A_HEADS, A_HEAD_DIM), qk_gain[0]), rope)
    ka = apply_rope_2d(rms_norm(heads(ka, A_KV_HEADS, A_HEAD_DIM), qk_gain[1]), rope)
    ka_x = rms_norm(heads(ka_x, A_KV_HEADS, A_HEAD_DIM), qk_gain[1])
    va_x = heads(va_x, A_KV_HEADS, A_HEAD_DIM)
    k_all = jnp.concatenate([ka, ka_x], axis=1).transpose(0, 2, 1, 3)
    v_all = jnp.concatenate([heads(va, A_KV_HEADS, A_HEAD_DIM), va_x], axis=1).transpose(0, 2, 1, 3)
    o_a = gqa_latent(qa, k_all, v_all)
    kb_x = heads(kb_x, B_HEADS, B_HEAD_DIM)
    vb_x = heads(vb_x, B_HEADS, B_HEAD_DIM)
    o_b = neighborhood_latent(heads(qb, B_HEADS, B_HEAD_DIM), heads(kb, B_HEADS, B_HEAD_DIM),
                              heads(vb, B_HEADS, B_HEAD_DIM), kb_x, vb_x, rpb)
    s0 = jnp.zeros((2, b, C_HEADS, C_HEAD_DIM, C_HEAD_DIM), jnp.float32)
    o_c_x, s_ctx = gdn_branch(short_conv(qkv_cx, conv_w), a_cx, b_cx, gate_cx, a_log, dt_bias,
                              o_gain, s0, need_ctx)
    o_c, _ = gdn_branch(short_conv(qkv_c, conv_w), a_c, b_c, gate_c, a_log, dt_bias,
                        o_gain, s_ctx, True)
    out = merge_branches((o_a, o_b, o_c), mg, w_branch, w_out)
    if not need_ctx:
        return out, None
    o_a_x = dense_attention(rms_norm(heads(qa_x, A_HEADS, A_HEAD_DIM), qk_gain[0]), ka_x, va_x)
    o_b_x = dense_attention(heads(qb_x, B_HEADS, B_HEAD_DIM), kb_x, vb_x)
    out_x = merge_branches((o_a_x, o_b_x, o_c_x), mg_x, w_branch, w_out)
    return out, out_x


def expert_choice_ffn(h, w_router, w_gate_up, w_down):
    b, n, _ = h.shape
    cap = CAPACITY * n // N_EXPERTS
    aff = jax.nn.softmax(jnp.einsum('bnd,de->bne', h, w_router).astype(jnp.float32), axis=-1)
    gate, idx = lax.top_k(jnp.swapaxes(aff, 1, 2), cap)
    bidx = jnp.arange(b)[:, None, None]
    xs = h[bidx, idx]
    gu = jnp.einsum('becd,edf->becf', xs, w_gate_up)
    g_, u_ = jnp.split(gu, 2, axis=-1)
    y = jnp.einsum('becf,efd->becd', jax.nn.silu(g_) * u_, w_down)
    y = y * gate[..., None].astype(y.dtype)
    return jnp.zeros_like(h).at[bidx, idx].add(y)


def setup_inputs(seed: int = 0) -> dict:
    key = jax.random.key(seed)
    ks = jax.random.split(key, 24)
    f32 = jnp.float32

    def nrm(k, shape, s):
        return jax.random.normal(k, shape, f32) * s

    x = nrm(ks[0], (BATCH, SEQ, D_MODEL), 1.0)
    c = nrm(ks[1], (BATCH, D_MODEL), 1.0)
    ctx = nrm(ks[2], (BATCH, CTX_LEN, D_MODEL), 1.0)
    c_ctx = nrm(ks[3], (D_MODEL,), 1.0)
    w_mod = nrm(ks[4], (DEPTH, D_MODEL, N_MOD * D_MODEL), 0.5 * D_MODEL ** -0.5)
    b_mod = nrm(ks[5], (DEPTH, N_MOD * D_MODEL), 0.02)
    w_in = nrm(ks[6], (DEPTH, D_MODEL, D_IN), D_MODEL ** -0.5)
    qk_gain = 1.0 + nrm(ks[7], (DEPTH, 2, A_HEAD_DIM), 0.05)
    rpb = nrm(ks[8], (DEPTH, B_HEADS, 2 * NA_ROWS - 1, 2 * NA_COLS - 1), 0.1)
    conv_w = nrm(ks[9], (DEPTH, CONV_K, 3 * C_W), CONV_K ** -0.5)
    a_log = jnp.log(jax.random.uniform(ks[10], (DEPTH, 2, C_HEADS), f32, 1.0, 16.0))
    dt = jnp.exp(jax.random.uniform(ks[11], (DEPTH, 2, C_HEADS), f32, math.log(1e-3), math.log(1e-1)))
    dt_bias = dt + jnp.log(-jnp.expm1(-dt))
    o_gain = 1.0 + nrm(ks[12], (DEPTH, C_HEAD_DIM), 0.05)
    w_branch = nrm(ks[13], (DEPTH, N_BRANCH, BRANCH_W, D_MODEL), BRANCH_W ** -0.5)
    w_out = nrm(ks[14], (DEPTH, D_MODEL, D_MODEL), D_MODEL ** -0.5 * DEEPNORM_BETA)
    ln1_g = 1.0 + nrm(ks[15], (DEPTH, D_MODEL), 0.05)
    ln1_b = nrm(ks[16], (DEPTH, D_MODEL), 0.02)
    w_router = nrm(ks[17], (DEPTH, D_MODEL, N_EXPERTS), D_MODEL ** -0.5)
    w_gate_up = nrm(ks[18], (DEPTH, N_EXPERTS, D_MODEL, 2 * D_EXPERT), D_MODEL ** -0.5)
    w_down = nrm(ks[19], (DEPTH, N_EXPERTS, D_EXPERT, D_MODEL), D_EXPERT ** -0.5 * DEEPNORM_BETA)
    ln2_g = 1.0 + nrm(ks[20], (DEPTH, D_MODEL), 0.05)
    ln2_b = nrm(ks[21], (DEPTH, D_MODEL), 0.02)
    return {'x': x, 'c': c, 'ctx': ctx, 'c_ctx': c_ctx, 'w_mod': w_mod, 'b_mod': b_mod,
            'w_in': w_in, 'qk_gain': qk_gain, 'rpb': rpb, 'conv_w': conv_w, 'a_log': a_log,
            'dt_bias': dt_bias, 'o_gain': o_gain, 'w_branch': w_branch, 'w_out': w_out,
            'ln1_g': ln1_g, 'ln1_b': ln1_b, 'w_router': w_router, 'w_gate_up': w_gate_up,
            'w_down': w_down, 'ln2_g': ln2_g, 'ln2_b': ln2_b}


def reference(x, c, ctx, c_ctx, w_mod, b_mod, w_in, qk_gain, rpb, conv_w, a_log, dt_bias, o_gain,
              w_branch, w_out, ln1_g, ln1_b, w_router, w_gate_up, w_down, ln2_g, ln2_b):
    rope = rope_tables(x.shape[1], x.dtype)
    c_act = jax.nn.silu(c)
    cc_act = jax.nn.silu(c_ctx)
    for layer in range(DEPTH):
        need_ctx = layer < DEPTH - 1
        mod = jnp.split((c_act @ w_mod[layer] + b_mod[layer])[:, None, :], N_MOD, axis=-1)
        mod_x = jnp.split(cc_act @ w_mod[layer] + b_mod[layer], N_MOD, axis=-1)
        h = modulate(layer_norm(x), mod[0], mod[1])
        h_x = modulate(layer_norm(ctx), mod_x[0], mod_x[1])
        mix, mix_x = token_mixers(h, h_x, rope, w_in[layer], qk_gain[layer], rpb[layer], conv_w[layer],
                                  a_log[layer], dt_bias[layer], o_gain[layer], w_branch[layer],
                                  w_out[layer], need_ctx)
        x = layer_norm_affine(DEEPNORM_ALPHA * x + mod[2] * mix, ln1_g[layer], ln1_b[layer])
        h = modulate(layer_norm(x), mod[3], mod[4])
        moe = expert_choice_ffn(h, w_router[layer], w_gate_up[layer], w_down[layer])
        x = layer_norm_affine(DEEPNORM_ALPHA * x + mod[5] * moe, ln2_g[layer], ln2_b[layer])
        if need_ctx:
            ctx = layer_norm_affine(DEEPNORM_ALPHA * ctx + mod_x[2] * mix_x, ln1_g[layer], ln1_b[layer])
            h_x = modulate(layer_norm(ctx), mod_x[3], mod_x[4])
            moe_x = expert_choice_ffn(h_x, w_router[layer], w_gate_up[layer], w_down[layer])
            ctx = layer_norm_affine(DEEPNORM_ALPHA * ctx + mod_x[5] * moe_x, ln2_g[layer], ln2_b[layer])
    return x
```

```cpp
#ifndef HOST_TEST
#include <hip/hip_runtime.h>
#endif
#include <cstdio>
#include <cstdint>
#include <cstring>
#include <cmath>

#ifndef CFG_SMALL
constexpr int D_MODEL = 1024, BATCH = 8, SEQ = 4096, DEPTH = 4, GRID_W = 64, CTX_LEN = 256;
constexpr int A_HEADS = 8, A_KV_HEADS = 2, HD = 64;
constexpr int B_HEADS = 8, NA_ROWS = 8, NA_COLS = 16;
constexpr int C_HEADS = 8, CONV_K = 4;
constexpr int N_EXPERTS = 16, D_EXPERT = 2048, CAPACITY = 2;
#else
constexpr int D_MODEL = 128, BATCH = 2, SEQ = CFG_SEQ, DEPTH = 2, GRID_W = CFG_GRID_W, CTX_LEN = 64;
constexpr int A_HEADS = 4, A_KV_HEADS = 2, HD = 16;
constexpr int B_HEADS = 4, NA_ROWS = 8, NA_COLS = 16;
constexpr int C_HEADS = 4, CONV_K = 4;
constexpr int N_EXPERTS = 4, D_EXPERT = 64, CAPACITY = 2;
#endif
constexpr int N_BRANCH = 3, BRANCH_W = A_HEADS * HD, N_MOD = 6;
constexpr float LN_EPS = 1e-6f, ROPE_THETA = 10000.0f;
constexpr int A_Q_W = A_HEADS * HD, A_KV_W = A_KV_HEADS * HD, B_W = B_HEADS * HD, C_W = C_HEADS * HD;
constexpr int D_IN = A_Q_W + 2 * A_KV_W + 3 * B_W + 3 * C_W + C_W + 4 * C_HEADS + N_BRANCH * D_MODEL;
static_assert(B_W == BRANCH_W && C_W == BRANCH_W, "branch widths");
constexpr int OC_QA = 0, OC_KA = OC_QA + A_Q_W, OC_VA = OC_KA + A_KV_W, OC_QB = OC_VA + A_KV_W, OC_KB = OC_QB + B_W, OC_VB = OC_KB + B_W,
              OC_QKVC = OC_VB + B_W, OC_GC = OC_QKVC + 3 * C_W, OC_A = OC_GC + C_W, OC_B = OC_A + 2 * C_HEADS, OC_MG = OC_B + 2 * C_HEADS;
static_assert(OC_MG + N_BRANCH * D_MODEL == D_IN, "D_IN");
constexpr int ZC_QA = OC_QA, ZC_KA = OC_KA, ZC_VA = OC_VA, ZC_QB = OC_QB, ZC_KB = OC_KB, ZC_VB = OC_VB, ZC_QKVC = OC_QKVC, ZC_GC = OC_GC, ZC_A = OC_A, ZC_B = OC_B;
constexpr int ZC_MG = (OC_MG + 255) / 256 * 256, ZN = ZC_MG + N_BRANCH * D_MODEL;
constexpr int NLAT = BATCH * SEQ, NCTX = BATCH * CTX_LEN, NTOK = NLAT + NCTX, KVLEN = SEQ + CTX_LEN;
constexpr size_t KVB_BYTES = (size_t)BATCH * B_HEADS * KVLEN * HD * 2;
constexpr int CAP_L = CAPACITY * SEQ / N_EXPERTS, CAP_C = CAPACITY * CTX_LEN / N_EXPERTS;
constexpr int NSLOT_L = BATCH * N_EXPERTS * CAP_L, NSLOT_C = BATCH * N_EXPERTS * CAP_C, NSLOT = NSLOT_L + NSLOT_C;
constexpr int GU_BLK = D_EXPERT >= 128 ? 128 : D_EXPERT;
constexpr int GRID_H = SEQ / GRID_W, WIN_R = NA_ROWS < GRID_H ? NA_ROWS : GRID_H;
constexpr int NFREQ = HD / 4, ROPE_P = GRID_H > GRID_W ? GRID_H : GRID_W;
constexpr float LOG2E = 1.4426950408889634f;
#ifndef CFG_SMALL
constexpr float QSCALE = 0.125f * LOG2E;
#else
constexpr float QSCALE = 0.25f * LOG2E;
#endif

typedef unsigned short bf16_t;

#ifdef HOST_TEST
#define HD_FN inline
#define GLOBAL_FN static
#define UNROLL
struct Dim3H { int x; };
static Dim3H threadIdx{0}, blockIdx{0}, blockDim{1}, gridDim{1};
#else
#define HD_FN __host__ __device__ __forceinline__
#define GLOBAL_FN __device__ __forceinline__
#define UNROLL _Pragma("unroll")
#endif
#define GSTRIDE_LOOP(i, n) for (long i = (long)blockIdx.x * blockDim.x + threadIdx.x; i < (long)(n); i += (long)gridDim.x * blockDim.x)

HD_FN float bf2f(bf16_t v) { unsigned u = (unsigned)v << 16; float f; memcpy(&f, &u, 4); return f; }
HD_FN bf16_t f2bf(float f) { unsigned u; memcpy(&u, &f, 4); u += 0x7fffu + ((u >> 16) & 1u); return (bf16_t)(u >> 16); }
HD_FN float siluf(float x) { return x / (1.0f + expf(-x)); }
HD_FN float sigmoidf(float x) { return 1.0f / (1.0f + expf(-x)); }
HD_FN float softplusf(float x) { return x > 20.f ? x : log1pf(expf(x)); }
HD_FN void sincos_rr(float x, float& s, float& c) {
#ifdef HOST_TEST
    s = sinf(x); c = cosf(x);
#else
    const float k = rintf(x * 0.15915494309189535f); float r = fmaf(-k, 6.28318548202514648f, x); r = fmaf(-k, -1.7484555e-7f, r);
    s = __sinf(r); c = __cosf(r);
#endif
}
HD_FN int clampi(int v, int lo, int hi) { return v < lo ? lo : (v > hi ? hi : v); }
HD_FN int zcol2orig(int n) { return n < OC_MG ? n : (n < ZC_MG ? -1 : n - (ZC_MG - OC_MG)); }
HD_FN int gu_row(int half, int c) { return (c / GU_BLK) * (2 * GU_BLK) + half * GU_BLK + (c % GU_BLK); }
HD_FN int mod_set(int r) { return r < NLAT ? r / SEQ : BATCH; }
HD_FN int slot_expert(int s) { return s < NSLOT_L ? s / (BATCH * CAP_L) : (s - NSLOT_L) / (BATCH * CAP_C); }

struct WS {
    bf16_t *WinT, *WbrT, *WoutT, *WguT, *WdnT;
    float *MOD;
    float *ROPE;
    float *X;
    bf16_t *H;
    bf16_t *Z;
    bf16_t *QA;
    bf16_t *KA, *VA;
    bf16_t *QC, *KC, *VC;
    unsigned char *GOP;
    float *SDEC;
    float *G, *BETA;
    float *OCD;
    bf16_t *OA, *OB, *OC;
    bf16_t *MB;
    bf16_t *GT;
    float *AFF;
    int *TOKLIST;
    float *GATEV;
    int *SLOTOF;
    bf16_t *XS;
    bf16_t *ACT;
    bf16_t *YS;
    unsigned *CTL;
};
struct Inputs {
    const float *x, *c, *ctx, *c_ctx, *w_mod, *b_mod, *w_in, *qk_gain, *rpb, *conv_w, *a_log, *dt_bias, *o_gain, *w_branch, *w_out,
        *ln1_g, *ln1_b, *w_router, *w_gate_up, *w_down, *ln2_g, *ln2_b;
};
struct KArgs { const float* in[22]; unsigned char* ws; float* out; int l, i1, i2, pad; };
HD_FN Inputs make_inputs(const KArgs& ka) { const float* const* p = ka.in;
    return Inputs{p[0], p[1], p[2], p[3], p[4], p[5], p[6], p[7], p[8], p[9], p[10], p[11], p[12], p[13], p[14], p[15], p[16], p[17], p[18], p[19], p[20], p[21]}; }
struct WSOff { size_t GT, CTL, WinT, WbrT, WoutT, WguT, WdnT, MOD, ROPE, X, H, Z, QA, KA, VA, QC, KC, VC, GOP, SDEC, G, BETA, OCD, OA, OB, OC, MB, AFF, TOKLIST, GATEV, SLOTOF, XS, ACT, YS, total; };
constexpr size_t al256(size_t b) { return (b + 255) / 256 * 256; }
constexpr WSOff ws_offsets() {
    WSOff o{}; size_t off = 0;
#define TAKE(name, bytes) o.name = off; off += al256((size_t)(bytes));
    TAKE(CTL, 1 << 20)
    TAKE(WinT, (size_t)DEPTH * ZN * D_MODEL * 2) TAKE(WbrT, (size_t)DEPTH * N_BRANCH * D_MODEL * BRANCH_W * 2) TAKE(WoutT, (size_t)DEPTH * D_MODEL * D_MODEL * 2)
    TAKE(WguT, (size_t)DEPTH * N_EXPERTS * 2 * D_EXPERT * D_MODEL * 2) TAKE(WdnT, (size_t)DEPTH * N_EXPERTS * D_MODEL * D_EXPERT * 2)
    TAKE(MOD, (size_t)DEPTH * (BATCH + 1) * N_MOD * D_MODEL * 4) TAKE(ROPE, (size_t)ROPE_P * NFREQ * 2 * 4)
    TAKE(X, (size_t)NTOK * D_MODEL * 4) TAKE(H, (size_t)NTOK * D_MODEL * 2) TAKE(Z, (size_t)NTOK * ZN * 2) TAKE(QA, (size_t)NTOK * A_Q_W * 2)
    TAKE(KA, (size_t)BATCH * KVLEN * A_KV_W * 2) TAKE(VA, (size_t)BATCH * KVLEN * A_KV_W * 2)
    TAKE(QC, (size_t)NTOK * C_W * 2) TAKE(KC, (size_t)NTOK * C_W * 2) TAKE(VC, (size_t)NTOK * C_W * 2)
    TAKE(GOP, (size_t)2 * BATCH * C_HEADS * (KVLEN / 64) * 41984) TAKE(SDEC, (size_t)2 * BATCH * C_HEADS * (KVLEN / 64) * 4) TAKE(G, (size_t)NTOK * 2 * C_HEADS * 4) TAKE(BETA, (size_t)NTOK * 2 * C_HEADS * 4)
    TAKE(OCD, (size_t)2 * NTOK * C_W * 4) TAKE(OA, (size_t)NTOK * BRANCH_W * 2) TAKE(OB, (size_t)NTOK * BRANCH_W * 2) TAKE(OC, (size_t)NTOK * BRANCH_W * 2) TAKE(MB, (size_t)NTOK * D_MODEL * 2) TAKE(GT, (size_t)NTOK * N_BRANCH * D_MODEL * 2)
    TAKE(AFF, (size_t)NTOK * N_EXPERTS * 4) TAKE(TOKLIST, (size_t)NSLOT * 4) TAKE(GATEV, (size_t)NSLOT * 4) TAKE(SLOTOF, (size_t)NTOK * N_EXPERTS * 4)
    TAKE(XS, (size_t)NSLOT * D_MODEL * 2) TAKE(ACT, (size_t)NSLOT * D_EXPERT * 2) TAKE(YS, (size_t)NSLOT * D_MODEL * 2)
#undef TAKE
    o.total = off; return o;
}
constexpr WSOff WSO = ws_offsets();
HD_FN unsigned char* ws_at(unsigned char* b, size_t off) {
#if defined(__HIP_DEVICE_COMPILE__)
    unsigned lo = (unsigned)off; asm volatile("" : "+s"(lo)); return b + (size_t)lo + ((off >> 32) << 32);
#else
    return b + off;
#endif
}
HD_FN WS make_ws(unsigned char* b) { WS w;
#define SETP(name, type) w.name = (type*)ws_at(b, WSO.name);
    SETP(CTL, unsigned) SETP(WinT, bf16_t) SETP(WbrT, bf16_t) SETP(WoutT, bf16_t) SETP(WguT, bf16_t) SETP(WdnT, bf16_t) SETP(MOD, float) SETP(ROPE, float) SETP(X, float) SETP(H, bf16_t) SETP(Z, bf16_t)
    SETP(QA, bf16_t) SETP(KA, bf16_t) SETP(VA, bf16_t) SETP(QC, bf16_t) SETP(KC, bf16_t) SETP(VC, bf16_t) SETP(GOP, unsigned char) SETP(SDEC, float) SETP(G, float) SETP(BETA, float) SETP(OCD, float) SETP(OA, bf16_t) SETP(OB, bf16_t) SETP(OC, bf16_t)
    SETP(MB, bf16_t) SETP(GT, bf16_t) SETP(AFF, float) SETP(TOKLIST, int) SETP(GATEV, float) SETP(SLOTOF, int) SETP(XS, bf16_t) SETP(ACT, bf16_t) SETP(YS, bf16_t)
#undef SETP
    return w; }


GLOBAL_FN void p_prep_weights(const KArgs& ka, const int l = 0, const int sh = 0, const int sc = 0) { const Inputs in = make_inputs(ka); const WS w = make_ws(ka.ws); (void)ka; (void)l; (void)sh; (void)sc;
    GSTRIDE_LOOP(i, (long)DEPTH * ZN * D_MODEL) {
        const int k = (int)(i % D_MODEL); const long t = i / D_MODEL; const int n = (int)(t % ZN), l = (int)(t / ZN);
        const int o = zcol2orig(n);
        w.WinT[i] = o >= 0 ? f2bf(in.w_in[((size_t)l * D_MODEL + k) * D_IN + o]) : (bf16_t)0;
    }
    GSTRIDE_LOOP(i, (long)DEPTH * N_BRANCH * D_MODEL * BRANCH_W) {
        const int k = (int)(i % BRANCH_W); const long t = i / BRANCH_W; const int n = (int)(t % D_MODEL); const long lb = t / D_MODEL;
        w.WbrT[i] = f2bf(in.w_branch[((size_t)lb * BRANCH_W + k) * D_MODEL + n]);
    }
    GSTRIDE_LOOP(i, (long)DEPTH * D_MODEL * D_MODEL) {
        const int k = (int)(i % D_MODEL); const long t = i / D_MODEL; const int n = (int)(t % D_MODEL), l = (int)(t / D_MODEL);
        w.WoutT[i] = f2bf(in.w_out[((size_t)l * D_MODEL + k) * D_MODEL + n]);
    }
    GSTRIDE_LOOP(i, (long)DEPTH * N_EXPERTS * 2 * D_EXPERT * D_MODEL) {
        const int k = (int)(i % D_MODEL); const long t = i / D_MODEL; const int row = (int)(t % (2 * D_EXPERT)); const long le = t / (2 * D_EXPERT);
        const int blk = row / (2 * GU_BLK), rem = row % (2 * GU_BLK), half = rem / GU_BLK, c = blk * GU_BLK + rem % GU_BLK;
        w.WguT[i] = f2bf(in.w_gate_up[((size_t)le * D_MODEL + k) * (2 * D_EXPERT) + half * D_EXPERT + c]);
    }
    GSTRIDE_LOOP(i, (long)DEPTH * N_EXPERTS * D_MODEL * D_EXPERT) {
        const int k = (int)(i % D_EXPERT); const long t = i / D_EXPERT; const int n = (int)(t % D_MODEL); const long le = t / D_MODEL;
        w.WdnT[i] = f2bf(in.w_down[((size_t)le * D_EXPERT + k) * D_MODEL + n]);
    }
}

GLOBAL_FN void p_mod_init(const KArgs& ka, const int l = 0, const int sh = 0, const int sc = 0) { const Inputs in = make_inputs(ka); const WS w = make_ws(ka.ws); (void)ka; (void)l; (void)sh; (void)sc;
    GSTRIDE_LOOP(i, (long)DEPTH * (BATCH + 1) * N_MOD * D_MODEL) {
        const int j = (int)(i % (N_MOD * D_MODEL)); const long t = i / (N_MOD * D_MODEL); const int s = (int)(t % (BATCH + 1)), l = (int)(t / (BATCH + 1));
        const float* cv = s < BATCH ? in.c + (size_t)s * D_MODEL : in.c_ctx;
        float acc = 0.f;
        for (int k = 0; k < D_MODEL; ++k) acc += siluf(cv[k]) * in.w_mod[((size_t)l * D_MODEL + k) * (N_MOD * D_MODEL) + j];
        w.MOD[i] = acc + in.b_mod[(size_t)l * N_MOD * D_MODEL + j];
    }
    GSTRIDE_LOOP(i, (long)NTOK * D_MODEL) w.X[i] = i < (long)NLAT * D_MODEL ? in.x[i] : in.ctx[i - (long)NLAT * D_MODEL];
    GSTRIDE_LOOP(i, (long)ROPE_P * NFREQ) { const int f = (int)(i % NFREQ), p = (int)(i / NFREQ); const float inv = exp2f(-(float)f / NFREQ * 13.287712379549449f);
        float s, c; sincos_rr((float)p * inv, s, c); w.ROPE[2 * i] = c; w.ROPE[2 * i + 1] = s; }
}

HD_FN const float* modp(const WS& w, int l, int r, int which) { return w.MOD + (((size_t)l * (BATCH + 1) + mod_set(r)) * N_MOD + which) * D_MODEL; }

GLOBAL_FN void p_ln_mod(const KArgs& ka, const int l = 0, const int sh = 0, const int sc = 0) { const WS w = make_ws(ka.ws);    (void)ka; (void)l; (void)sh; (void)sc;
    GSTRIDE_LOOP(r, NTOK) {
        const float* x = w.X + (size_t)r * D_MODEL; float mu = 0.f, var = 0.f;
        for (int c = 0; c < D_MODEL; ++c) mu += x[c];
        mu /= D_MODEL;
        for (int c = 0; c < D_MODEL; ++c) { const float d = x[c] - mu; var += d * d; }
        const float rs = 1.0f / sqrtf(var / D_MODEL + LN_EPS);
        const float *ms = modp(w, l, (int)r, sh), *mc = modp(w, l, (int)r, sc);
        for (int c = 0; c < D_MODEL; ++c) w.H[(size_t)r * D_MODEL + c] = f2bf((x[c] - mu) * rs * (1.0f + mc[c]) + ms[c]);
    }
}

HD_FN float dot_bf(const bf16_t* a, const bf16_t* b, int K) { float s = 0.f; for (int k = 0; k < K; ++k) s += bf2f(a[k]) * bf2f(b[k]); return s; }

GLOBAL_FN void p_gemm_in_naive(const KArgs& ka, const int l = 0, const int sh = 0, const int sc = 0) { const WS w = make_ws(ka.ws);  (void)ka; (void)l; (void)sh; (void)sc;
    GSTRIDE_LOOP(i, (long)NTOK * ZN) { const int n = (int)(i % ZN); const long r = i / ZN;
        const float zv = dot_bf(w.H + (size_t)r * D_MODEL, w.WinT + ((size_t)l * ZN + n) * D_MODEL, D_MODEL) * ((n >= ZC_QB && n < ZC_QB + B_W) ? QSCALE : 1.0f);
        w.Z[i] = f2bf(n >= ZC_MG ? sigmoidf(zv) : zv); }
}

GLOBAL_FN void p_prep_a(const KArgs& ka, const int l = 0, const int sh = 0, const int sc = 0) { const Inputs in = make_inputs(ka); const WS w = make_ws(ka.ws);  (void)ka; (void)l; (void)sh; (void)sc;
    GSTRIDE_LOOP(i, (long)NTOK * (A_HEADS + 2 * A_KV_HEADS)) {
        const int hh = (int)(i % (A_HEADS + 2 * A_KV_HEADS)); const int r = (int)(i / (A_HEADS + 2 * A_KV_HEADS));
        const bool lat = r < NLAT; const int b = lat ? r / SEQ : (r - NLAT) / CTX_LEN, t = lat ? r % SEQ : (r - NLAT) % CTX_LEN;
        const size_t kvrow = (size_t)b * KVLEN + (lat ? t : SEQ + t);
        if (hh >= A_HEADS + A_KV_HEADS) { const int kvh = hh - A_HEADS - A_KV_HEADS;
            UNROLL for (int d = 0; d < HD; ++d) w.VA[kvrow * A_KV_W + kvh * HD + d] = w.Z[(size_t)r * ZN + ZC_VA + kvh * HD + d];
            continue; }
        const bool isq = hh < A_HEADS; const int hq = isq ? hh : hh - A_HEADS;
        const bf16_t* src = w.Z + (size_t)r * ZN + (isq ? ZC_QA : ZC_KA) + hq * HD;
        const float* gain = in.qk_gain + ((size_t)l * 2 + (isq ? 0 : 1)) * HD;
        float v[HD]; float ss = 0.f;
        UNROLL for (int d = 0; d < HD; ++d) { v[d] = bf2f(src[d]); ss += v[d] * v[d]; }
        const float rs = 1.0f / sqrtf(ss / HD + LN_EPS);
        UNROLL for (int d = 0; d < HD; ++d) v[d] = v[d] * rs * gain[d];
        if (lat) { const float* tr = w.ROPE + (size_t)(t / GRID_W) * NFREQ * 2; const float* tc = w.ROPE + (size_t)(t % GRID_W) * NFREQ * 2;
            UNROLL for (int f = 0; f < NFREQ; ++f) { const float cr = tr[2 * f], sr = tr[2 * f + 1], cc = tc[2 * f], sc = tc[2 * f + 1];
                const float x1 = v[f], x2 = v[NFREQ + f], x3 = v[2 * NFREQ + f], x4 = v[3 * NFREQ + f];
                v[f] = x1 * cr - x2 * sr; v[NFREQ + f] = x2 * cr + x1 * sr; v[2 * NFREQ + f] = x3 * cc - x4 * sc; v[3 * NFREQ + f] = x4 * cc + x3 * sc; } }
        if (isq) { UNROLL for (int d = 0; d < HD; ++d) w.QA[(size_t)r * A_Q_W + hq * HD + d] = f2bf(v[d] * QSCALE); }
        else UNROLL for (int d = 0; d < HD; ++d) w.KA[kvrow * A_KV_W + hq * HD + d] = f2bf(v[d]);
    }
}

GLOBAL_FN void p_prep_c(const KArgs& ka, const int l = 0, const int sh = 0, const int sc = 0) { const Inputs in = make_inputs(ka); const WS w = make_ws(ka.ws);  (void)ka; (void)l; (void)sh; (void)sc;
    GSTRIDE_LOOP(i, (long)NTOK * C_HEADS) {
        const int h = (int)(i % C_HEADS); const int r = (int)(i / C_HEADS);
        const bool lat = r < NLAT; const int t = lat ? r % SEQ : (r - NLAT) % CTX_LEN, len = lat ? SEQ : CTX_LEN;
        UNROLL for (int part = 0; part < 3; ++part) {
            float v[HD]; float ss = 0.f;
            UNROLL for (int d = 0; d < HD; ++d) { const int ch = part * C_W + h * HD + d; float y = 0.f;
                for (int j = 0; j < CONV_K; ++j) { const int tt = t + j - CONV_K / 2; if (tt >= 0 && tt < len) y += bf2f(w.Z[(size_t)(r + tt - t) * ZN + ZC_QKVC + ch]) * in.conv_w[((size_t)l * CONV_K + j) * (3 * C_W) + ch]; }
                v[d] = siluf(y); ss += v[d] * v[d]; }
            float sc = 1.f; if (part < 2) sc = 1.0f / sqrtf(ss + LN_EPS); if (part == 0) sc *= 1.0f / sqrtf((float)HD);
            bf16_t* dst = (part == 0 ? w.QC : part == 1 ? w.KC : w.VC) + (size_t)r * C_W + h * HD;
            UNROLL for (int d = 0; d < HD; ++d) dst[d] = f2bf(v[d] * sc);
        }
        for (int dir = 0; dir < 2; ++dir) {
            const float a = bf2f(w.Z[(size_t)r * ZN + ZC_A + dir * C_HEADS + h]), bt = bf2f(w.Z[(size_t)r * ZN + ZC_B + dir * C_HEADS + h]);
            w.G[((size_t)r * 2 + dir) * C_HEADS + h] = -expf(in.a_log[((size_t)l * 2 + dir) * C_HEADS + h]) * softplusf(a + in.dt_bias[((size_t)l * 2 + dir) * C_HEADS + h]);
            w.BETA[((size_t)r * 2 + dir) * C_HEADS + h] = sigmoidf(bt);
        }
    }
}

GLOBAL_FN void p_attn_a_naive(const KArgs& ka, const int l = 0, const int sh = 0, const int sc = 0) { const WS w = make_ws(ka.ws); (void)ka; (void)l; (void)sh; (void)sc;
    GSTRIDE_LOOP(i, (long)NTOK * A_HEADS) {
        const int h = (int)(i % A_HEADS); const int r = (int)(i / A_HEADS);
        const bool lat = r < NLAT; const int b = lat ? r / SEQ : (r - NLAT) / CTX_LEN;
        const int kvh = h / (A_HEADS / A_KV_HEADS), m0 = lat ? 0 : SEQ;
        float q[HD], o[HD]; UNROLL for (int d = 0; d < HD; ++d) { q[d] = bf2f(w.QA[(size_t)r * A_Q_W + h * HD + d]); o[d] = 0.f; }
        float mx = -INFINITY, lsum = 0.f;
        for (int m = m0; m < KVLEN; ++m) {
            const bf16_t* kp = w.KA + ((size_t)b * KVLEN + m) * A_KV_W + kvh * HD; const bf16_t* vp = w.VA + ((size_t)b * KVLEN + m) * A_KV_W + kvh * HD;
            float s = 0.f; UNROLL for (int d = 0; d < HD; ++d) s += q[d] * bf2f(kp[d]);
            const float nm = s > mx ? s : mx, f = exp2f(mx - nm), p = exp2f(s - nm);
            lsum = lsum * f + p; UNROLL for (int d = 0; d < HD; ++d) o[d] = o[d] * f + p * bf2f(vp[d]); mx = nm;
        }
        UNROLL for (int d = 0; d < HD; ++d) w.OA[(size_t)r * BRANCH_W + h * HD + d] = f2bf(o[d] / lsum);
    }
}

GLOBAL_FN void p_attn_b_naive(const KArgs& ka, const int l = 0, const int sh = 0, const int sc = 0) { const Inputs in = make_inputs(ka); const WS w = make_ws(ka.ws);  (void)ka; (void)l; (void)sh; (void)sc;
    GSTRIDE_LOOP(i, (long)(sh ? NLAT : NTOK) * B_HEADS) {
        const int h = (int)(i % B_HEADS); const int r = (int)(i / B_HEADS);
        const bool lat = r < NLAT; const int b = lat ? r / SEQ : (r - NLAT) / CTX_LEN, t = lat ? r % SEQ : 0;
        float q[HD], o[HD]; UNROLL for (int d = 0; d < HD; ++d) { q[d] = bf2f(w.Z[(size_t)r * ZN + ZC_QB + h * HD + d]); o[d] = 0.f; }
        float mx = -INFINITY, lsum = 0.f;
        const int row = t / GRID_W, col = t % GRID_W, rs = clampi(row - WIN_R / 2, 0, GRID_H - WIN_R), cs = clampi(col - NA_COLS / 2, 0, GRID_W - NA_COLS);
        const int nnb = lat ? WIN_R * NA_COLS : 0;
        for (int m = 0; m < nnb + CTX_LEN; ++m) {
            size_t krow; float bias = 0.f;
            if (m < nnb) { const int kr = rs + m / NA_COLS, kc = cs + m % NA_COLS; krow = (size_t)b * SEQ + kr * GRID_W + kc;
                bias = in.rpb[(((size_t)l * B_HEADS + h) * (2 * NA_ROWS - 1) + (kr - row + NA_ROWS - 1)) * (2 * NA_COLS - 1) + (kc - col + NA_COLS - 1)] * LOG2E; }
            else krow = (size_t)NLAT + (size_t)b * CTX_LEN + (m - nnb);
            const bf16_t* kp = w.Z + krow * ZN + ZC_KB + h * HD; const bf16_t* vp = w.Z + krow * ZN + ZC_VB + h * HD;
            float s = bias; UNROLL for (int d = 0; d < HD; ++d) s += q[d] * bf2f(kp[d]);
            const float nm = s > mx ? s : mx, f = exp2f(mx - nm), p = exp2f(s - nm);
            lsum = lsum * f + p; UNROLL for (int d = 0; d < HD; ++d) o[d] = o[d] * f + p * bf2f(vp[d]); mx = nm;
        }
        UNROLL for (int d = 0; d < HD; ++d) w.OB[(size_t)r * BRANCH_W + h * HD + d] = f2bf(o[d] / lsum);
    }
}

GLOBAL_FN void p_gdn_naive(const KArgs& ka, const int l = 0, const int sh = 0, const int sc = 0) { const WS w = make_ws(ka.ws); (void)ka; (void)l; (void)sh; (void)sc;
    GSTRIDE_LOOP(i, (long)2 * BATCH * C_HEADS * HD) {
        const int j = (int)(i % HD); long t_ = i / HD; const int h = (int)(t_ % C_HEADS); t_ /= C_HEADS; const int b = (int)(t_ % BATCH), dir = (int)(t_ / BATCH);
        float S[HD]; UNROLL for (int k = 0; k < HD; ++k) S[k] = 0.f;
        for (int seg = 0; seg < 2; ++seg) {
            const int len = seg == 0 ? CTX_LEN : SEQ; const size_t base = seg == 0 ? (size_t)NLAT + (size_t)b * CTX_LEN : (size_t)b * SEQ;
            for (int s = 0; s < len; ++s) {
                const size_t r = base + (dir == 0 ? s : len - 1 - s);
                const bf16_t* kp = w.KC + r * C_W + h * HD; const bf16_t* qp = w.QC + r * C_W + h * HD;
                const float a = expf(w.G[(r * 2 + dir) * C_HEADS + h]), be = w.BETA[(r * 2 + dir) * C_HEADS + h], vj = bf2f(w.VC[r * C_W + h * HD + j]);
                float ks = 0.f; UNROLL for (int k = 0; k < HD; ++k) ks += bf2f(kp[k]) * S[k];
                const float dl = be * (vj - a * ks);
                float o = 0.f; UNROLL for (int k = 0; k < HD; ++k) { S[k] = a * S[k] + bf2f(kp[k]) * dl; o += bf2f(qp[k]) * S[k]; }
                w.OCD[((size_t)dir * NTOK + r) * C_W + h * HD + j] = o;
            }
        }
    }
}
GLOBAL_FN void p_gdn_fin(const KArgs& ka, const int l = 0, const int sh = 0, const int sc = 0) { const Inputs in = make_inputs(ka); const WS w = make_ws(ka.ws);  (void)ka; (void)l; (void)sh; (void)sc;
    GSTRIDE_LOOP(i, (long)NTOK * C_HEADS) {
        const int h = (int)(i % C_HEADS); const size_t r = (size_t)(i / C_HEADS);
        float o[HD]; float ss = 0.f;
        UNROLL for (int d = 0; d < HD; ++d) { o[d] = w.OCD[r * C_W + h * HD + d] + w.OCD[((size_t)NTOK + r) * C_W + h * HD + d]; ss += o[d] * o[d]; }
        const float rs = 1.0f / sqrtf(ss / HD + LN_EPS);
        UNROLL for (int d = 0; d < HD; ++d) w.OC[r * BRANCH_W + h * HD + d] = f2bf(o[d] * rs * in.o_gain[(size_t)l * HD + d] * siluf(bf2f(w.Z[r * ZN + ZC_GC + h * HD + d])));
    }
}

GLOBAL_FN void p_branch_naive(const KArgs& ka, const int l = 0, const int sh = 0, const int sc = 0) { const WS w = make_ws(ka.ws);  (void)ka; (void)l; (void)sh; (void)sc;
    GSTRIDE_LOOP(i, (long)NTOK * D_MODEL) { const int c = (int)(i % D_MODEL); const size_t r = (size_t)(i / D_MODEL); float m = 0.f;
        for (int br = 0; br < N_BRANCH; ++br) { const bf16_t* o = (br == 0 ? w.OA : br == 1 ? w.OB : w.OC) + r * BRANCH_W;
            m += bf2f(w.Z[r * ZN + ZC_MG + br * D_MODEL + c]) * dot_bf(o, w.WbrT + (((size_t)l * N_BRANCH + br) * D_MODEL + c) * BRANCH_W, BRANCH_W); }
        w.MB[i] = f2bf(m); }
}
constexpr float DEEPNORM_ALPHA_HOST = 0.f;
HD_FN float deepnorm_alpha() { return sqrtf(sqrtf(2.0f * DEPTH)); }
GLOBAL_FN void p_out_naive(const KArgs& ka, const int l = 0, const int sh = 0, const int sc = 0) { const WS w = make_ws(ka.ws);  (void)ka; (void)l; (void)sh; (void)sc;
    GSTRIDE_LOOP(i, (long)NTOK * D_MODEL) { const int c = (int)(i % D_MODEL); const int r = (int)(i / D_MODEL);
        const float mix = dot_bf(w.MB + (size_t)r * D_MODEL, w.WoutT + ((size_t)l * D_MODEL + c) * D_MODEL, D_MODEL);
        w.X[i] = deepnorm_alpha() * w.X[i] + modp(w, l, r, 2)[c] * mix; }
}
GLOBAL_FN void p_ln1_router(const KArgs& ka, const int l = 0, const int sh = 0, const int sc = 0) { const Inputs in = make_inputs(ka); const WS w = make_ws(ka.ws);  (void)ka; (void)l; (void)sh; (void)sc;
    GSTRIDE_LOOP(r, NTOK) {
        float* x = w.X + (size_t)r * D_MODEL; float mu = 0.f, var = 0.f;
        for (int c = 0; c < D_MODEL; ++c) mu += x[c];
        mu /= D_MODEL;
        for (int c = 0; c < D_MODEL; ++c) { const float d = x[c] - mu; var += d * d; }
        float rs = 1.0f / sqrtf(var / D_MODEL + LN_EPS);
        float mu2 = 0.f;
        for (int c = 0; c < D_MODEL; ++c) { x[c] = (x[c] - mu) * rs * in.ln1_g[(size_t)l * D_MODEL + c] + in.ln1_b[(size_t)l * D_MODEL + c]; mu2 += x[c]; }
        mu2 /= D_MODEL; var = 0.f;
        for (int c = 0; c < D_MODEL; ++c) { const float d = x[c] - mu2; var += d * d; }
        rs = 1.0f / sqrtf(var / D_MODEL + LN_EPS);
        const float *ms = modp(w, l, (int)r, 3), *mc = modp(w, l, (int)r, 4);
        float lg[N_EXPERTS]; UNROLL for (int e = 0; e < N_EXPERTS; ++e) lg[e] = 0.f;
        for (int c = 0; c < D_MODEL; ++c) { const float hv = (x[c] - mu2) * rs * (1.0f + mc[c]) + ms[c]; w.H[(size_t)r * D_MODEL + c] = f2bf(hv);
            UNROLL for (int e = 0; e < N_EXPERTS; ++e) lg[e] += hv * in.w_router[((size_t)l * D_MODEL + c) * N_EXPERTS + e]; }
        float mx = lg[0]; UNROLL for (int e = 1; e < N_EXPERTS; ++e) mx = lg[e] > mx ? lg[e] : mx;
        float sm = 0.f; UNROLL for (int e = 0; e < N_EXPERTS; ++e) { lg[e] = expf(lg[e] - mx); sm += lg[e]; }
        UNROLL for (int e = 0; e < N_EXPERTS; ++e) w.AFF[(size_t)r * N_EXPERTS + e] = lg[e] / sm;
    }
}
GLOBAL_FN void p_topk_naive(const KArgs& ka, const int l = 0, const int sh = 0, const int sc = 0) { const WS w = make_ws(ka.ws); (void)ka; (void)l; (void)sh; (void)sc;
    GSTRIDE_LOOP(i, (long)NTOK * N_EXPERTS) {
        const int e = (int)(i % N_EXPERTS); const int r = (int)(i / N_EXPERTS);
        const bool lat = r < NLAT; const int b = lat ? r / SEQ : (r - NLAT) / CTX_LEN, len = lat ? SEQ : CTX_LEN, cap = lat ? CAP_L : CAP_C;
        const int base = lat ? b * SEQ : NLAT + b * CTX_LEN; const float mine = w.AFF[(size_t)r * N_EXPERTS + e];
        int rank = 0;
        for (int t = 0; t < len; ++t) { const float o = w.AFF[(size_t)(base + t) * N_EXPERTS + e]; rank += (o > mine || (o == mine && base + t < r)) ? 1 : 0; }
        int slot = -1;
        if (rank < cap) { slot = lat ? (e * BATCH + b) * CAP_L + rank : NSLOT_L + (e * BATCH + b) * CAP_C + rank; w.TOKLIST[slot] = r; w.GATEV[slot] = mine; }
        w.SLOTOF[i] = slot;
    }
}
GLOBAL_FN void p_gather_xs(const KArgs& ka, const int l = 0, const int sh = 0, const int sc = 0) { const WS w = make_ws(ka.ws); (void)ka; (void)l; (void)sh; (void)sc;
    GSTRIDE_LOOP(i, (long)NSLOT * D_MODEL / 8) { const int c8 = (int)(i % (D_MODEL / 8)); const int s = (int)(i / (D_MODEL / 8));
        for (int j = 0; j < 8; ++j) w.XS[(size_t)s * D_MODEL + c8 * 8 + j] = w.H[(size_t)w.TOKLIST[s] * D_MODEL + c8 * 8 + j]; }
}
GLOBAL_FN void p_moe1_naive(const KArgs& ka, const int l = 0, const int sh = 0, const int sc = 0) { const WS w = make_ws(ka.ws);  (void)ka; (void)l; (void)sh; (void)sc;
    GSTRIDE_LOOP(i, (long)NSLOT * D_EXPERT) { const int c = (int)(i % D_EXPERT); const int s = (int)(i / D_EXPERT); const int e = slot_expert(s);
        const bf16_t* a = w.H + (size_t)w.TOKLIST[s] * D_MODEL; const bf16_t* wt = w.WguT + ((size_t)l * N_EXPERTS + e) * 2 * D_EXPERT * D_MODEL;
        const float g = dot_bf(a, wt + (size_t)gu_row(0, c) * D_MODEL, D_MODEL), u = dot_bf(a, wt + (size_t)gu_row(1, c) * D_MODEL, D_MODEL);
        w.ACT[i] = f2bf(siluf(g) * u); }
}
GLOBAL_FN void p_moe2_naive(const KArgs& ka, const int l = 0, const int sh = 0, const int sc = 0) { const WS w = make_ws(ka.ws);  (void)ka; (void)l; (void)sh; (void)sc;
    GSTRIDE_LOOP(i, (long)NSLOT * D_MODEL) { const int c = (int)(i % D_MODEL); const int s = (int)(i / D_MODEL); const int e = slot_expert(s);
        w.YS[i] = f2bf(w.GATEV[s] * dot_bf(w.ACT + (size_t)s * D_EXPERT, w.WdnT + (((size_t)l * N_EXPERTS + e) * D_MODEL + c) * D_EXPERT, D_EXPERT)); }
}
GLOBAL_FN void p_ln2(const KArgs& ka, const int l = 0, const int sh = 0, const int sc = 0) { const Inputs in = make_inputs(ka); const WS w = make_ws(ka.ws);  float* out = ka.out; (void)ka; (void)l; (void)sh; (void)sc;
    GSTRIDE_LOOP(r, NTOK) {
        float* x = w.X + (size_t)r * D_MODEL; const float* m5 = modp(w, l, (int)r, 5); float mu = 0.f, var = 0.f;
        for (int c = 0; c < D_MODEL; ++c) { float moe = 0.f;
            UNROLL for (int e = 0; e < N_EXPERTS; ++e) { const int s = w.SLOTOF[(size_t)r * N_EXPERTS + e]; if (s >= 0) moe += bf2f(w.YS[(size_t)s * D_MODEL + c]); }
            x[c] = deepnorm_alpha() * x[c] + m5[c] * moe; mu += x[c]; }
        mu /= D_MODEL;
        for (int c = 0; c < D_MODEL; ++c) { const float d = x[c] - mu; var += d * d; }
        float rs = 1.0f / sqrtf(var / D_MODEL + LN_EPS);
        float mu2 = 0.f;
        for (int c = 0; c < D_MODEL; ++c) { x[c] = (x[c] - mu) * rs * in.ln2_g[(size_t)l * D_MODEL + c] + in.ln2_b[(size_t)l * D_MODEL + c]; mu2 += x[c]; }
        if (l == DEPTH - 1) { if (r < NLAT) for (int c = 0; c < D_MODEL; ++c) out[(size_t)r * D_MODEL + c] = x[c]; continue; }
        mu2 /= D_MODEL; var = 0.f;
        for (int c = 0; c < D_MODEL; ++c) { const float d = x[c] - mu2; var += d * d; }
        rs = 1.0f / sqrtf(var / D_MODEL + LN_EPS);
        const float *ms = modp(w, l + 1, (int)r, 0), *mc = modp(w, l + 1, (int)r, 1);
        for (int c = 0; c < D_MODEL; ++c) w.H[(size_t)r * D_MODEL + c] = f2bf((x[c] - mu2) * rs * (1.0f + mc[c]) + ms[c]);
    }
}


#ifndef HOST_TEST
constexpr int KTID_TAB_OFF = 131072 + 512;
__device__ __forceinline__ int ktid() {
    extern __shared__ __attribute__((aligned(16))) unsigned char lds_all_[];
    const unsigned key = (unsigned)__builtin_amdgcn_s_getreg((5 << 11) | 4) & 63u;
    const int w = __builtin_amdgcn_readfirstlane(((const volatile __attribute__((address_space(3))) int*)((__attribute__((address_space(3))) unsigned char*)lds_all_ + KTID_TAB_OFF))[key]);
    int ln; asm volatile("v_mbcnt_lo_u32_b32 %0, -1, 0\n\tv_mbcnt_hi_u32_b32 %0, -1, %0" : "=v"(ln));
    return w * 64 + ln;
}
__device__ __forceinline__ float shf_idx(float v, int src) { return __int_as_float(__builtin_amdgcn_ds_bpermute(src << 2, __float_as_int(v))); }
__device__ __forceinline__ unsigned shu_idx(unsigned v, int src) { return (unsigned)__builtin_amdgcn_ds_bpermute(src << 2, (int)v); }
__device__ __forceinline__ int shi_idx(int v, int src) { return __builtin_amdgcn_ds_bpermute(src << 2, v); }
namespace pg8 {
#define PG8_LAS __attribute__((address_space(3)))
typedef short bf16x8 __attribute__((ext_vector_type(8)));
typedef float f32x4 __attribute__((ext_vector_type(4)));
typedef unsigned u32x4 __attribute__((ext_vector_type(4)));
typedef unsigned u32x2 __attribute__((ext_vector_type(2)));
constexpr int BM = 256, BK = 64, HALF = 128, HTB = HALF * BK * 2, STAGE_BYTES = 8 * HTB, NXCD = 8, WGM = 8, TOK_OFF = 8 * HTB + 2048, ROWV_OFF = 8 * HTB + 4096;
__host__ __device__ __forceinline__ int lds_byte(int r, int c) { const int st = (r >> 4) * 2 + (c >> 5), rr = r & 15, cc = c & 31, ob = rr * 64 + cc * 2; return st * 1024 + (ob ^ (((ob >> 9) & 1) << 5)); }
__host__ __device__ __forceinline__ void stage_rc(int b, int& R, int& C) { const int st = b / 1024, sb = b % 1024, swz = sb ^ (((sb >> 9) & 1) << 5); R = (st >> 1) * 16 + swz / 64; C = (st & 1) * 32 + (swz % 64) / 2; }
__host__ __device__ __forceinline__ int perm32(int rho) { const int n = rho >> 4, i = rho & 15; return 8 * (i >> 2) + 4 * n + (i & 3); }
struct Unit { int pm, pn, aux; };
typedef float f32x2_t __attribute__((ext_vector_type(2))); typedef __bf16 bf16x2_t __attribute__((ext_vector_type(2)));
__device__ __forceinline__ unsigned cvt_pk_bf16(float lo, float hi) { const f32x2_t v = {lo, hi}; return __builtin_bit_cast(unsigned, __builtin_convertvector(v, bf16x2_t)); }
__device__ __forceinline__ bool order_mn(int i, int G, int c, int nM, int nN, int& pm, int& pn) {
    const int nwg = nM * nN; const long L = (long)i * G + c; if (L >= nwg) return false;
    int wgid = (int)L; { const int q = nwg / NXCD, r = nwg % NXCD, xcd = wgid % NXCD, off = wgid / NXCD; wgid = (xcd < r ? xcd * (q + 1) : r * (q + 1) + (xcd - r) * q) + off; }
    const int nig = WGM * nN, gid = wgid / nig, fm = gid * WGM, gsz = (nM - fm) < WGM ? (nM - fm) : WGM;
    pm = fm + ((wgid % nig) % gsz); pn = (wgid % nig) / gsz; return true;
}
template <class Epi, class Sched, bool ALIGN_EPI = true, bool SP2 = true, bool GATHER = false>
__device__ __forceinline__ void gemm_phase(PG8_LAS unsigned char* lds, const int K, const Sched& S, const Epi& E) {
    int tid_ = ktid(); asm volatile("" : "+v"(tid_));
    const int tid = tid_, wid = __builtin_amdgcn_readfirstlane(tid >> 6), lane = tid & 63, wr = wid >> 2, wc = wid & 3, fr = lane & 15, fq = lane >> 4;
    const int nt = K / BK;
    static_assert(!GATHER || SP2, "the gathered A path is wired into the SP2 loop only");
    unsigned voffA[2], voffB[2]; int gR[2]; unsigned gC[2];
#pragma unroll
    for (int i = 0; i < 2; ++i) { int R, C; stage_rc(tid * 16 + i * 8192, R, C); const int Rb = Epi::PERM ? ((R & ~31) + perm32(R & 31)) : R;
        voffA[i] = (unsigned)(R * K + C) * 2u; voffB[i] = (unsigned)(Rb * K + C) * 2u; gR[i] = R; gC[i] = (unsigned)C * 2u; }
    unsigned cvA[2][2], nvA[2][2];
#define PG8_GFILL(dst, u) do { _Pragma("unroll") for (int _h = 0; _h < 2; ++_h) _Pragma("unroll") for (int _i = 0; _i < 2; ++_i) dst[_h][_i] = (unsigned)S.atok((u), _h * HALF + gR[_i]) * (unsigned)(K * 2) + gC[_i]; } while (0)
#define PG8_STAGE_A(bufoff, kp, h, nx) do { if constexpr (GATHER) { _Pragma("unroll") for (int _i = 0; _i < 2; ++_i) { const unsigned _o = (nx) ? nvA[h][_i] : cvA[h][_i]; \
        __builtin_amdgcn_global_load_lds((const unsigned*)((const char*)(kp) + _o), (PG8_LAS unsigned*)(lds + (bufoff) + ldsw + _i * 8192), 16, 0, 0); } } \
        else { PG8_STAGE(bufoff, (kp) + (h) * hstep, voffA); } } while (0)
    const size_t kstep = (size_t)(BK * 2);
    const size_t hstep = (size_t)HALF * K * 2;
    const unsigned ldsw = (unsigned)wid * 1024u;
    const int aoff = lds_byte(wr * 64 + fr, fq * 8), boff = lds_byte(wc * 32 + fr, fq * 8);
#define PG8_SA(b, h) (((b) * 2 + (h)) * HTB)
#define PG8_SB(b, h) ((4 + (b) * 2 + (h)) * HTB)
#define PG8_STAGE(bufoff, gbase, voff) do { _Pragma("unroll") for (int _i = 0; _i < 2; ++_i) \
        __builtin_amdgcn_global_load_lds((const unsigned*)((const char*)(gbase) + (voff)[_i]), (PG8_LAS unsigned*)(lds + (bufoff) + ldsw + _i * 8192), 16, 0, 0); } while (0)
#define PG8_LDA(dst, b, h) do { _Pragma("unroll") for (int m = 0; m < 4; ++m) _Pragma("unroll") for (int k = 0; k < 2; ++k) dst[m][k] = *(const PG8_LAS bf16x8*)(lds + PG8_SA(b, h) + aoff + m * 2048 + k * 1024); } while (0)
#define PG8_LDB(dst, b, h) do { _Pragma("unroll") for (int n = 0; n < 2; ++n) _Pragma("unroll") for (int k = 0; k < 2; ++k) dst[n][k] = *(const PG8_LAS bf16x8*)(lds + PG8_SB(b, h) + boff + n * 2048 + k * 1024); } while (0)
#define PG8_MMA(ai, bj, At, Bt) do { __builtin_amdgcn_s_setprio(1); _Pragma("unroll") for (int m = 0; m < 4; ++m) _Pragma("unroll") for (int n = 0; n < 2; ++n) _Pragma("unroll") for (int k = 0; k < 2; ++k) \
        acc[ai][bj][m][n] = __builtin_amdgcn_mfma_f32_16x16x32_bf16(Bt[n][k], At[m][k], acc[ai][bj][m][n], 0, 0, 0); __builtin_amdgcn_s_setprio(0); } while (0)
#define PG8_WAIT_V(n) asm volatile("s_waitcnt vmcnt(" #n ")" ::: "memory")
#define PG8_WAIT_L(n) asm volatile("s_waitcnt lgkmcnt(" #n ")" ::: "memory")
#define PG8_BAR __builtin_amdgcn_s_barrier()
#define PG8_SCHED __builtin_amdgcn_sched_barrier(0)
    Unit cur, nxt; int ui = 0;
    if (!S.next(0, cur)) return;
    f32x4 acc[2][2][4][2];
#pragma unroll
    for (int a = 0; a < 2; ++a)
#pragma unroll
        for (int b = 0; b < 2; ++b)
#pragma unroll
            for (int m = 0; m < 4; ++m)
#pragma unroll
                for (int n = 0; n < 2; ++n) acc[a][b][m][n] = (f32x4){0.f, 0.f, 0.f, 0.f};
    bf16x8 At[4][2], B0[2][2], B1[2][2];
    const char* cA = S.abase(cur); const char* cB = S.bbase(cur);
    if constexpr (GATHER) { PG8_GFILL(cvA, cur); }
    if constexpr (SP2) {
        PG8_STAGE(PG8_SB(0, 0), cB, voffB); PG8_STAGE(PG8_SB(0, 1), cB + hstep, voffB); PG8_STAGE_A(PG8_SA(0, 0), cA, 0, false); PG8_STAGE_A(PG8_SA(0, 1), cA, 1, false);
        if (wr == 1) PG8_BAR;
        PG8_WAIT_V(2); PG8_BAR;
        PG8_STAGE(PG8_SB(1, 0), cB + kstep, voffB); PG8_STAGE_A(PG8_SA(1, 0), cA + kstep, 0, false); PG8_STAGE(PG8_SB(1, 1), cB + hstep + kstep, voffB);
        PG8_WAIT_V(6); PG8_BAR;
    } else {
        PG8_STAGE(PG8_SB(0, 0), cB, voffB); PG8_STAGE(PG8_SA(0, 0), cA, voffA); PG8_STAGE(PG8_SB(0, 1), cB + hstep, voffB); PG8_STAGE(PG8_SA(0, 1), cA + hstep, voffA);
        if (wr == 1) PG8_BAR;
        PG8_WAIT_V(4); PG8_BAR;
        PG8_STAGE(PG8_SB(1, 0), cB + kstep, voffB); PG8_STAGE(PG8_SA(1, 0), cA + kstep, voffA); PG8_STAGE(PG8_SB(1, 1), cB + hstep + kstep, voffB);
        PG8_WAIT_V(6); PG8_BAR;
    }
    for (;;) {
        const bool has_next = S.next(ui + 1, nxt);
        const char* nA = has_next ? S.abase(nxt) : cA; const char* nB = has_next ? S.bbase(nxt) : cB;
        if constexpr (Epi::ROWV) { if (wid == 1) __builtin_amdgcn_global_load_lds((const unsigned*)(E.rowv(cur) + lane * 4), (PG8_LAS unsigned*)(lds + ROWV_OFF + (ui & 1) * 1024), 16, 0, 0); }
        if constexpr (GATHER) { if (has_next && wid == 0) __builtin_amdgcn_global_load_lds((const unsigned*)(S.toks(nxt) + lane * 4), (PG8_LAS unsigned*)(lds + TOK_OFF), 16, 0, 0); }
        for (int t = 0; t < nt; t += 2) {
            const bool last = (t == nt - 2);
            if constexpr (GATHER) { if (last) {
                if (has_next) { _Pragma("unroll") for (int _h = 0; _h < 2; ++_h) _Pragma("unroll") for (int _i = 0; _i < 2; ++_i) nvA[_h][_i] = ((const volatile PG8_LAS unsigned*)(lds + TOK_OFF))[_h * HALF + gR[_i]] * (unsigned)(K * 2) + gC[_i]; }
                else { _Pragma("unroll") for (int _h = 0; _h < 2; ++_h) _Pragma("unroll") for (int _i = 0; _i < 2; ++_i) nvA[_h][_i] = cvA[_h][_i]; } } }
            const char* a1 = cA + (size_t)(t + 1) * kstep;
            const char* a2 = last ? nA : cA + (size_t)(t + 2) * kstep; const char* b2 = last ? nB : cB + (size_t)(t + 2) * kstep;
            const char* a3 = a2 + kstep; const char* b3 = b2 + kstep;
            if constexpr (SP2) {
            PG8_LDB(B0, 0, 0); PG8_LDB(B1, 0, 1); PG8_SCHED; PG8_LDA(At, 0, 0); PG8_STAGE_A(PG8_SA(1, 1), a1, 1, false);
            PG8_WAIT_V(8); PG8_WAIT_L(0); PG8_BAR; PG8_MMA(0, 0, At, B0); PG8_MMA(0, 1, At, B1); PG8_BAR; PG8_SCHED;
            PG8_LDA(At, 0, 1); PG8_STAGE(PG8_SB(0, 0), b2, voffB); PG8_STAGE(PG8_SB(0, 1), b2 + hstep, voffB); PG8_STAGE_A(PG8_SA(0, 0), a2, 0, last);
            PG8_WAIT_V(8); PG8_WAIT_L(0); PG8_BAR; PG8_MMA(1, 0, At, B0); PG8_MMA(1, 1, At, B1); PG8_BAR; PG8_SCHED;
            PG8_LDB(B0, 1, 0); PG8_LDB(B1, 1, 1); PG8_SCHED; PG8_LDA(At, 1, 0); PG8_STAGE_A(PG8_SA(0, 1), a2, 1, last);
            PG8_WAIT_V(8); PG8_WAIT_L(0); PG8_BAR; PG8_MMA(0, 0, At, B0); PG8_MMA(0, 1, At, B1); PG8_BAR; PG8_SCHED;
            PG8_LDA(At, 1, 1); PG8_STAGE(PG8_SB(1, 0), b3, voffB); PG8_STAGE(PG8_SB(1, 1), b3 + hstep, voffB); PG8_STAGE_A(PG8_SA(1, 0), a3, 0, last);
            PG8_WAIT_V(8); PG8_WAIT_L(0); PG8_BAR; PG8_MMA(1, 0, At, B0); PG8_MMA(1, 1, At, B1); PG8_BAR; PG8_SCHED;
            } else {
            PG8_LDB(B0, 0, 0); PG8_SCHED; PG8_LDA(At, 0, 0); PG8_STAGE(PG8_SA(1, 1), a1 + hstep, voffA);
            PG8_WAIT_L(8); PG8_BAR; PG8_WAIT_L(0); PG8_MMA(0, 0, At, B0); PG8_BAR; PG8_SCHED;
            PG8_LDB(B1, 0, 1); PG8_STAGE(PG8_SB(0, 0), b2, voffB);
            PG8_BAR; PG8_WAIT_L(0); PG8_MMA(0, 1, At, B1); PG8_BAR;
            PG8_LDA(At, 0, 1); PG8_STAGE(PG8_SA(0, 0), a2, voffA);
            PG8_BAR; PG8_WAIT_L(0); PG8_MMA(1, 0, At, B0); PG8_BAR; PG8_SCHED;
            PG8_STAGE(PG8_SB(0, 1), b2 + hstep, voffB);
            PG8_WAIT_V(6); PG8_BAR; PG8_MMA(1, 1, At, B1); PG8_BAR;
            PG8_LDB(B0, 1, 0); PG8_SCHED; PG8_LDA(At, 1, 0); PG8_STAGE(PG8_SA(0, 1), a2 + hstep, voffA);
            PG8_WAIT_L(8); PG8_BAR; PG8_WAIT_L(0); PG8_MMA(0, 0, At, B0); PG8_BAR; PG8_SCHED;
            PG8_LDB(B1, 1, 1); PG8_STAGE(PG8_SB(1, 0), b3, voffB);
            PG8_BAR; PG8_WAIT_L(0); PG8_MMA(0, 1, At, B1); PG8_BAR;
            PG8_LDA(At, 1, 1); PG8_STAGE(PG8_SA(1, 0), a3, voffA);
            PG8_BAR; PG8_WAIT_L(0); PG8_MMA(1, 0, At, B0); PG8_BAR; PG8_SCHED;
            PG8_STAGE(PG8_SB(1, 1), b3 + hstep, voffB);
            PG8_WAIT_V(6); PG8_BAR; PG8_MMA(1, 1, At, B1); PG8_BAR;
            }
        }
        if constexpr (ALIGN_EPI) { if (wr == 0) PG8_BAR; }
        if constexpr (Epi::ROWV) E(acc, cur, wr, wc, fr, fq, (const PG8_LAS float*)(lds + ROWV_OFF + (ui & 1) * 1024)); else E(acc, cur, wr, wc, fr, fq);
        if (!has_next) break;
        bool keep_acc = false; if constexpr (Epi::CHAIN) keep_acc = E.keep(cur);
        if (!keep_acc) {
#pragma unroll
        for (int a = 0; a < 2; ++a)
#pragma unroll
            for (int b = 0; b < 2; ++b)
#pragma unroll
                for (int m = 0; m < 4; ++m)
#pragma unroll
                    for (int n = 0; n < 2; ++n) acc[a][b][m][n] = (f32x4){0.f, 0.f, 0.f, 0.f}; }
        cur = nxt; cA = nA; cB = nB; ++ui;
        if constexpr (GATHER) { _Pragma("unroll") for (int _h = 0; _h < 2; ++_h) _Pragma("unroll") for (int _i = 0; _i < 2; ++_i) cvA[_h][_i] = nvA[_h][_i]; }
        if constexpr (ALIGN_EPI) { if (wr == 1) PG8_BAR; }
    }
    PG8_WAIT_V(0);
    if constexpr (!ALIGN_EPI) { if (wr == 0) PG8_BAR; }
    PG8_BAR;
#undef PG8_SA
#undef PG8_SB
#undef PG8_STAGE
#undef PG8_STAGE_A
#undef PG8_GFILL
#undef PG8_LDA
#undef PG8_LDB
#undef PG8_MMA
#undef PG8_WAIT_V
#undef PG8_WAIT_L
#undef PG8_BAR
#undef PG8_SCHED
}
}

using pg8::f32x4; using pg8::u32x4; using pg8::u32x2; using pg8::Unit; using pg8::HALF; using pg8::BM;
__device__ __forceinline__ float fast_sigmoid(float x) { return __builtin_amdgcn_rcpf(1.0f + __builtin_amdgcn_exp2f(-x * LOG2E)); }
__device__ __forceinline__ f32x4 fast_sigmoid4(f32x4 x) { f32x4 e = x * (-LOG2E);
#pragma unroll
    for (int j = 0; j < 4; ++j) e[j] = __builtin_amdgcn_exp2f(e[j]);
    e = e + 1.0f;
#pragma unroll
    for (int j = 0; j < 4; ++j) e[j] = __builtin_amdgcn_rcpf(e[j]);
    return e; }
__device__ __forceinline__ float bflo(unsigned u) { return __uint_as_float(u << 16); }
__device__ __forceinline__ float bfhi(unsigned u) { return __uint_as_float(u & 0xffff0000u); }

struct SchedIn { __device__ __forceinline__ int atok(const Unit&, int) const { return 0; } const bf16_t* H; const bf16_t* WinT_l; int G, c;
    __device__ __forceinline__ bool next(int i, Unit& u) const { u.aux = 0; return pg8::order_mn(i, G, c, NTOK / BM, ZN / BM, u.pm, u.pn); }
    __device__ __forceinline__ const char* abase(const Unit& u) const { return (const char*)(H + (size_t)u.pm * BM * D_MODEL); }
    __device__ __forceinline__ const char* bbase(const Unit& u) const { return (const char*)(WinT_l + (size_t)u.pn * BM * D_MODEL); } };
struct SchedBranch { __device__ __forceinline__ int atok(const Unit&, int) const { return 0; } const bf16_t* OA; const bf16_t* WbrT_l; int G, c, nM;
    __device__ __forceinline__ bool next(int i, Unit& u) const { const int t = (i / N_BRANCH) * G + c; if (t >= nM * (D_MODEL / BM)) return false; u.aux = i % N_BRANCH; u.pm = t / (D_MODEL / BM); u.pn = t % (D_MODEL / BM); return true; }
    __device__ __forceinline__ const char* abase(const Unit& u) const { return (const char*)(OA + (size_t)u.aux * (WSO.OB - WSO.OA) / 2 + (size_t)u.pm * BM * BRANCH_W); }
    __device__ __forceinline__ const char* bbase(const Unit& u) const { return (const char*)(WbrT_l + ((size_t)u.aux * D_MODEL + (size_t)u.pn * BM) * BRANCH_W); } };
static_assert(WSO.OC - WSO.OB == WSO.OB - WSO.OA && WSO.OB - WSO.OA == (size_t)NTOK * BRANCH_W * 2 && 2 * BRANCH_W == D_MODEL, "branch outputs equally spaced and contiguous (OA|OB doubles as the [NTOK][D_MODEL] mix buffer)");
struct SchedOut { __device__ __forceinline__ int atok(const Unit&, int) const { return 0; } const bf16_t* MB; const bf16_t* WoutT_l; int G, c, nM;
    __device__ __forceinline__ bool next(int i, Unit& u) const { u.aux = 0; return pg8::order_mn(i, G, c, nM, D_MODEL / BM, u.pm, u.pn); }
    __device__ __forceinline__ const char* abase(const Unit& u) const { return (const char*)(MB + (size_t)u.pm * BM * D_MODEL); }
    __device__ __forceinline__ const char* bbase(const Unit& u) const { return (const char*)(WoutT_l + (size_t)u.pn * BM * D_MODEL); } };
struct SchedMoe1 { const bf16_t* H; const int* TOKLIST; const bf16_t* WguT_l; int G, c, nM;
    __device__ __forceinline__ bool next(int i, Unit& u) const { u.aux = 0; return pg8::order_mn(i, G, c, nM, 2 * D_EXPERT / BM, u.pm, u.pn); }
    __device__ __forceinline__ int atok(const Unit& u, int r) const { return TOKLIST[u.pm * BM + r]; }
    __device__ __forceinline__ const int* toks(const Unit& u) const { return TOKLIST + u.pm * BM; }
    __device__ __forceinline__ const char* abase(const Unit&) const { return (const char*)H; }
    __device__ __forceinline__ const char* bbase(const Unit& u) const { return (const char*)(WguT_l + ((size_t)slot_expert(u.pm * BM) * 2 * D_EXPERT + (size_t)u.pn * BM) * D_MODEL); } };
struct SchedMoe2 { __device__ __forceinline__ int atok(const Unit&, int) const { return 0; } const bf16_t* ACT; const bf16_t* WdnT_l; int G, c, nM;
    __device__ __forceinline__ bool next(int i, Unit& u) const { u.aux = 0; return pg8::order_mn(i, G, c, nM, D_MODEL / BM, u.pm, u.pn); }
    __device__ __forceinline__ const char* abase(const Unit& u) const { return (const char*)(ACT + (size_t)u.pm * BM * D_EXPERT); }
    __device__ __forceinline__ const char* bbase(const Unit& u) const { return (const char*)(WdnT_l + ((size_t)slot_expert(u.pm * BM) * D_MODEL + (size_t)u.pn * BM) * D_EXPERT); } };
static_assert(ZC_QB % BM == 0 && B_W % BM == 0 && ZC_KB % BM == 0 && ZC_VB % BM == 0 && ZC_VB == ZC_KB + B_W && HD == 64 && 2 * KVB_BYTES <= (size_t)NSLOT * D_MODEL * 2 && SEQ % BM == 0 && CTX_LEN % BM == 0, "mixer-B query / key / value columns are whole units; compact K / V fit the XS region");
static_assert(CAP_L % BM == 0 && (BATCH * CAP_C) % BM == 0 && NTOK % BM == 0 && ZN % BM == 0 && NSLOT % BM == 0, "unit shapes");

struct EpiZ { static constexpr bool ROWV = false; static constexpr bool CHAIN = false; static constexpr bool PERM = true; bf16_t* Z; bf16_t* GT; bf16_t* KVB;
    __device__ __forceinline__ void operator()(const f32x4 (&acc)[2][2][4][2], const Unit& u, int wr, int wc, int fr, int fq) const {
        const int row0 = u.pm * BM + wr * 64 + fr, col0 = u.pn * BM + wc * 32 + 8 * fq;
        const float sc = (u.pn * BM >= ZC_QB && u.pn * BM < ZC_QB + B_W) ? QSCALE : 1.0f;
        const bool gate = u.pn * BM >= ZC_MG;
        const int gcol = u.pn * BM - ZC_MG; bf16_t* gtp = GT + ((size_t)(((size_t)u.pm * (D_MODEL / BM) + (gcol % D_MODEL) / BM) * N_BRANCH + gcol / D_MODEL) * 16 * 512 + ((wr * 4 + wc) * 64 + fq * 16 + fr)) * 8;
        if (gate) {
#pragma unroll
            for (int ai = 0; ai < 2; ++ai)
#pragma unroll
                for (int m = 0; m < 4; ++m)
#pragma unroll
                    for (int bj = 0; bj < 2; ++bj) { const f32x4 v0 = fast_sigmoid4(acc[ai][bj][m][0]), v1 = fast_sigmoid4(acc[ai][bj][m][1]);
                        u32x4 o; o.x = pg8::cvt_pk_bf16(v0[0], v0[1]); o.y = pg8::cvt_pk_bf16(v0[2], v0[3]); o.z = pg8::cvt_pk_bf16(v1[0], v1[1]); o.w = pg8::cvt_pk_bf16(v1[2], v1[3]);
                        __builtin_nontemporal_store(o, (u32x4*)(gtp + (size_t)(((ai * 4 + m) * 2 + bj) * 512) * 8)); }
        } else if (u.pn * BM >= ZC_KB && u.pn * BM < ZC_VB + B_W) {
            const int isv = u.pn * BM >= ZC_VB ? 1 : 0, cu = u.pn * BM - (isv ? ZC_VB : ZC_KB), ur = u.pm * BM;
            const int bb = ur < NLAT ? ur / SEQ : (ur - NLAT) / CTX_LEN, t0 = ur < NLAT ? ur % SEQ : SEQ + (ur - NLAT) % CTX_LEN;
            bf16_t* kb = KVB + (size_t)isv * (KVB_BYTES / 2) + (size_t)(wc & 1) * 32 + 8 * fq;
#pragma unroll
            for (int ai = 0; ai < 2; ++ai)
#pragma unroll
                for (int m = 0; m < 4; ++m) { const int tl = t0 + wr * 64 + fr + ai * HALF + m * 16;
#pragma unroll
                    for (int bj = 0; bj < 2; ++bj) { const f32x4 v0 = acc[ai][bj][m][0], v1 = acc[ai][bj][m][1]; const int head = cu / HD + bj * 2 + (wc >> 1);
                        u32x4 o; o.x = pg8::cvt_pk_bf16(v0[0], v0[1]); o.y = pg8::cvt_pk_bf16(v0[2], v0[3]); o.z = pg8::cvt_pk_bf16(v1[0], v1[1]); o.w = pg8::cvt_pk_bf16(v1[2], v1[3]);
                        *(u32x4*)(kb + ((size_t)(bb * B_HEADS + head) * KVLEN + tl) * HD) = o; } }
        } else {
#pragma unroll
            for (int ai = 0; ai < 2; ++ai)
#pragma unroll
                for (int m = 0; m < 4; ++m) { bf16_t* rowp = Z + (size_t)(row0 + ai * HALF + m * 16) * ZN + col0;
#pragma unroll
                    for (int bj = 0; bj < 2; ++bj) { const f32x4 v0 = acc[ai][bj][m][0] * sc, v1 = acc[ai][bj][m][1] * sc;
                        u32x4 o; o.x = pg8::cvt_pk_bf16(v0[0], v0[1]); o.y = pg8::cvt_pk_bf16(v0[2], v0[3]); o.z = pg8::cvt_pk_bf16(v1[0], v1[1]); o.w = pg8::cvt_pk_bf16(v1[2], v1[3]);
                        __builtin_nontemporal_store(o, (u32x4*)(rowp + bj * HALF)); } }
        }
    } };
#define GB_N 8
#if GB_N == 8
#define GB_FENCE(a) asm volatile("" : "+v"(a[0]), "+v"(a[1]), "+v"(a[2]), "+v"(a[3]), "+v"(a[4]), "+v"(a[5]), "+v"(a[6]), "+v"(a[7]))
#else
#define GB_FENCE(a) asm volatile("" : "+v"(a[0]), "+v"(a[1]), "+v"(a[2]), "+v"(a[3]))
#endif
struct EpiBranch { static constexpr bool ROWV = false; static constexpr bool CHAIN = true; static constexpr bool PERM = true; const bf16_t* GT; bf16_t* MB;
    __device__ __forceinline__ bool keep(const Unit& u) const { return u.aux < N_BRANCH - 1; }
    __device__ __forceinline__ void operator()(f32x4 (&acc)[2][2][4][2], const Unit& u, int wr, int wc, int fr, int fq) const {
        const int row0 = u.pm * BM + wr * 64 + fr, col0 = u.pn * BM + wc * 32 + 8 * fq; const int br = u.aux; const bool lastb = br == N_BRANCH - 1;
        const bf16_t* gt0 = GT + ((size_t)(((size_t)u.pm * (D_MODEL / BM) + u.pn) * N_BRANCH + br) * 16 * 512 + ((wr * 4 + wc) * 64 + fq * 16 + fr)) * 8;
        u32x4 gb[GB_N], gnb[GB_N];
#pragma unroll
        for (int ai = 0; ai < 2; ++ai) {
#pragma unroll
            for (int m = 0; m < 4; ++m) { const size_t row = (size_t)(row0 + ai * HALF + m * 16);
#pragma unroll
                for (int bj = 0; bj < 2; ++bj) { const int col = col0 + bj * HALF;
                    if ((m * 2 + bj) % GB_N == 0 && !(lastb && ai == 1)) {
#pragma unroll
                        for (int q = 0; q < GB_N; ++q) { const bf16_t* gp = gt0 + (size_t)((ai * 8 + m * 2 + bj + q) * 512) * 8; gb[q] = *(const u32x4*)gp; gnb[q] = *(const u32x4*)(gp + (size_t)(lastb ? 8 : 16) * 512 * 8); }
                        GB_FENCE(gb); GB_FENCE(gnb); }
                    if (lastb && ai == 1 && m * 2 + bj == 0) {
#pragma unroll
                        for (int q = 0; q < GB_N; ++q) gb[q] = gnb[q]; }
                    const u32x4 g = gb[(m * 2 + bj) % GB_N]; const u32x4 gn = lastb ? g : gnb[(m * 2 + bj) % GB_N];
                    float f[8];
#pragma unroll
                    for (int e = 0; e < 4; ++e) { const float a0 = bflo(g[e]), a1 = bfhi(g[e]);
                        f[2 * e] = lastb ? a0 : a0 * __builtin_amdgcn_rcpf(fmaxf(bflo(gn[e]), 1e-30f)); f[2 * e + 1] = lastb ? a1 : a1 * __builtin_amdgcn_rcpf(fmaxf(bfhi(gn[e]), 1e-30f)); }
                    f32x4& a0v = acc[ai][bj][m][0]; f32x4& a1v = acc[ai][bj][m][1];
                    a0v[0] *= f[0]; a0v[1] *= f[1]; a0v[2] *= f[2]; a0v[3] *= f[3]; a1v[0] *= f[4]; a1v[1] *= f[5]; a1v[2] *= f[6]; a1v[3] *= f[7];
                    if (lastb) { u32x4 o; o.x = pg8::cvt_pk_bf16(a0v[0], a0v[1]); o.y = pg8::cvt_pk_bf16(a0v[2], a0v[3]); o.z = pg8::cvt_pk_bf16(a1v[0], a1v[1]); o.w = pg8::cvt_pk_bf16(a1v[2], a1v[3]);
                        *(u32x4*)(MB + row * D_MODEL + col) = o; } } } }
    } };
struct EpiOut { static constexpr bool ROWV = false; static constexpr bool CHAIN = false; static constexpr bool PERM = true; bf16_t* MIX;
    __device__ __forceinline__ void operator()(const f32x4 (&acc)[2][2][4][2], const Unit& u, int wr, int wc, int fr, int fq) const {
        const int row0 = u.pm * BM + wr * 64 + fr, col0 = u.pn * BM + wc * 32 + 8 * fq;
#pragma unroll
        for (int ai = 0; ai < 2; ++ai)
#pragma unroll
            for (int m = 0; m < 4; ++m) { bf16_t* rowp = MIX + (size_t)(row0 + ai * HALF + m * 16) * D_MODEL + col0;
#pragma unroll
                for (int bj = 0; bj < 2; ++bj) { const f32x4 v0 = acc[ai][bj][m][0], v1 = acc[ai][bj][m][1];
                    u32x4 o; o.x = pg8::cvt_pk_bf16(v0[0], v0[1]); o.y = pg8::cvt_pk_bf16(v0[2], v0[3]); o.z = pg8::cvt_pk_bf16(v1[0], v1[1]); o.w = pg8::cvt_pk_bf16(v1[2], v1[3]);
                    *(u32x4*)(rowp + bj * HALF) = o; } }
    } };
static_assert(SEQ % BM == 0 && CTX_LEN % BM == 0, "modulation set per unit");
struct EpiGU { static constexpr bool ROWV = false; static constexpr bool CHAIN = false; static constexpr bool PERM = true; bf16_t* ACT;
    __device__ __forceinline__ void operator()(const f32x4 (&acc)[2][2][4][2], const Unit& u, int wr, int wc, int fr, int fq) const {
        const int row0 = u.pm * BM + wr * 64 + fr, col0 = u.pn * HALF + wc * 32 + 8 * fq;
#pragma unroll
        for (int ai = 0; ai < 2; ++ai)
#pragma unroll
            for (int m = 0; m < 4; ++m) { const f32x4 r0 = acc[ai][0][m][0] * acc[ai][1][m][0] * fast_sigmoid4(acc[ai][0][m][0]), r1 = acc[ai][0][m][1] * acc[ai][1][m][1] * fast_sigmoid4(acc[ai][0][m][1]);
                u32x4 o; o.x = pg8::cvt_pk_bf16(r0[0], r0[1]); o.y = pg8::cvt_pk_bf16(r0[2], r0[3]); o.z = pg8::cvt_pk_bf16(r1[0], r1[1]); o.w = pg8::cvt_pk_bf16(r1[2], r1[3]);
                __builtin_nontemporal_store(o, (u32x4*)(ACT + (size_t)(row0 + ai * HALF + m * 16) * D_EXPERT + col0)); }
    } };
static_assert(GU_BLK == HALF, "gate/up interleave matches the unit's two column halves");
struct EpiDown { static constexpr bool ROWV = true; static constexpr bool CHAIN = false; static constexpr bool PERM = true; const float* GATEV; bf16_t* YS;
    __device__ __forceinline__ const float* rowv(const Unit& u) const { return GATEV + (size_t)u.pm * BM; }
    __device__ __forceinline__ void operator()(const f32x4 (&acc)[2][2][4][2], const Unit& u, int wr, int wc, int fr, int fq, const PG8_LAS float* gl) const {
        const int row0 = u.pm * BM + wr * 64 + fr, col0 = u.pn * BM + wc * 32 + 8 * fq;
        float gv[2][4];
#pragma unroll
        for (int ai = 0; ai < 2; ++ai)
#pragma unroll
            for (int m = 0; m < 4; ++m) gv[ai][m] = gl[wr * 64 + fr + ai * HALF + m * 16];
#pragma unroll
        for (int ai = 0; ai < 2; ++ai)
#pragma unroll
            for (int m = 0; m < 4; ++m) { const int row = row0 + ai * HALF + m * 16; const float gt = gv[ai][m]; bf16_t* rowp = YS + (size_t)row * D_MODEL + col0;
#pragma unroll
                for (int bj = 0; bj < 2; ++bj) { const f32x4 v0 = acc[ai][bj][m][0] * gt, v1 = acc[ai][bj][m][1] * gt;
                    u32x4 o; o.x = pg8::cvt_pk_bf16(v0[0], v0[1]); o.y = pg8::cvt_pk_bf16(v0[2], v0[3]); o.z = pg8::cvt_pk_bf16(v1[0], v1[1]); o.w = pg8::cvt_pk_bf16(v1[2], v1[3]);
                    *(u32x4*)(rowp + bj * HALF) = o; } }
    } };

#include <hip/hip_bf16.h>
namespace attn_body {
using bf16=__hip_bfloat16;
using bf16x8=__attribute__((ext_vector_type(8)))short;
using s16x4=__attribute__((ext_vector_type(4)))short;
using f32x16=__attribute__((ext_vector_type(16)))float;
using u32x4=__attribute__((ext_vector_type(4)))unsigned;
constexpr int D=64;
constexpr int NW=8,QBLK=32,QB=QBLK*NW,KVBLK=64;
constexpr int ATTN_UNIT_ROWS=QB;
__device__ __forceinline__ int crow(int r,int hi){return (r&3)+8*(r>>2)+4*hi;}
#define SBAR() __builtin_amdgcn_sched_barrier(0)
__device__ __forceinline__ void cmask(f32x16&p0,f32x16&p1,int jb,int qrel,int hi){
  const float NEG=-INFINITY; int kb=64*jb+4*hi;
  #pragma unroll
  for(int r=0;r<16;++r){int kv=kb+(r&3)+8*(r>>2); if(kv>qrel)p0[r]=NEG; if(kv+32>qrel)p1[r]=NEG;}
}

constexpr int NSLOT=3, SLOTB=8192;
constexpr int LDS_K=0, LDS_V=NSLOT*SLOTB, LDS_WS=2*NSLOT*SLOTB, LDS_OST=LDS_WS+NW*64*4, LDS_BYTES=LDS_OST+NW*4096;
constexpr float C2=0.125f*1.4426950408889634f;
__device__ __forceinline__ void glds16(const void*gsrc,unsigned lds_dst){unsigned keep;
  asm volatile("s_mov_b32 %0, m0\n\ts_mov_b32 m0, %2\n\ts_nop 0\n\tglobal_load_lds_dwordx4 %1, off\n\ts_mov_b32 m0, %0":"=&s"(keep):"v"(gsrc),"s"(lds_dst):"memory");}
__device__ __forceinline__ float max3f(float a,float b,float c){float r;asm("v_max3_f32 %0, %1, %2, %3":"=v"(r):"v"(a),"v"(b),"v"(c));return r;}
__device__ __forceinline__ float max2f(float a,float b){float r;asm("v_max_f32_e32 %0, %1, %2":"=v"(r):"v"(a),"v"(b));return r;}
__device__ __forceinline__ float fadd_s(float a,float b){float r;asm("v_add_f32_e32 %0, %1, %2":"=v"(r):"v"(a),"v"(b));return r;}
__device__ __forceinline__ float fsub_s(float a,float b){float r;asm("v_sub_f32_e32 %0, %1, %2":"=v"(r):"v"(a),"v"(b));return r;}
typedef float f32x2_t __attribute__((ext_vector_type(2))); typedef __bf16 bf16x2_t __attribute__((ext_vector_type(2)));
__device__ __forceinline__ unsigned cvtpk_s(float lo,float hi){f32x2_t v={lo,hi};bf16x2_t b=__builtin_convertvector(v,bf16x2_t);return __builtin_bit_cast(unsigned,b);}
#define WAIT_BAR(N) asm volatile("s_waitcnt vmcnt(" #N ") lgkmcnt(0)\n\ts_barrier":::"memory")

__device__ __forceinline__ void qkt(f32x16&p0,f32x16&p1,const char*Kslot,const bf16x8*qr,const f32x16&negm,int r32,int hi){
  const char*kb=Kslot+hi*1024+r32*16;
  #pragma unroll
  for(int d0=0;d0<4;++d0){
    const bf16x8 b0=*reinterpret_cast<const bf16x8*>(kb+d0*2048);
    const bf16x8 b1=*reinterpret_cast<const bf16x8*>(kb+d0*2048+512);
    if(d0==0){p0=__builtin_amdgcn_mfma_f32_32x32x16_bf16(b0,qr[0],negm,0,0,0);p1=__builtin_amdgcn_mfma_f32_32x32x16_bf16(b1,qr[0],negm,0,0,0);}
    else{p0=__builtin_amdgcn_mfma_f32_32x32x16_bf16(b0,qr[d0],p0,0,0,0);p1=__builtin_amdgcn_mfma_f32_32x32x16_bf16(b1,qr[d0],p1,0,0,0);}}
}
typedef __attribute__((address_space(3))) const char* lds_cptr;
typedef short v4i16_t __attribute__((ext_vector_type(4)));
__device__ __forceinline__ void kload8(bf16x8*kf,lds_cptr kp){
  kf[0]=*(const __attribute__((address_space(3))) bf16x8*)(kp);      kf[1]=*(const __attribute__((address_space(3))) bf16x8*)(kp+512);
  kf[2]=*(const __attribute__((address_space(3))) bf16x8*)(kp+2048); kf[3]=*(const __attribute__((address_space(3))) bf16x8*)(kp+2560);
  kf[4]=*(const __attribute__((address_space(3))) bf16x8*)(kp+4096); kf[5]=*(const __attribute__((address_space(3))) bf16x8*)(kp+4608);
  kf[6]=*(const __attribute__((address_space(3))) bf16x8*)(kp+6144); kf[7]=*(const __attribute__((address_space(3))) bf16x8*)(kp+6656);
}
__device__ __forceinline__ void kload2(bf16x8*kf,lds_cptr kp,int j){ kf[2*j]=*(const __attribute__((address_space(3))) bf16x8*)(kp+j*2048); kf[2*j+1]=*(const __attribute__((address_space(3))) bf16x8*)(kp+j*2048+512); }
__device__ __forceinline__ s16x4 vtr(lds_cptr p){ return __builtin_bit_cast(s16x4,__builtin_amdgcn_ds_read_tr16_b64_v4i16((__attribute__((address_space(3))) v4i16_t*)p)); }
__device__ __forceinline__ float rowmax(const f32x16&p0,const f32x16&p1){
  float a=max3f(p0[0],p0[1],p1[0]),b=max3f(p0[2],p0[3],p1[1]);a=max3f(a,p1[2],p1[3]);
  #pragma unroll
  for(int r=4;r<16;r+=4){a=max3f(a,p0[r],p0[r+1]);b=max3f(b,p0[r+2],p0[r+3]);a=max3f(a,p1[r],p1[r+1]);b=max3f(b,p1[r+2],p1[r+3]);}
  const float m=max2f(a,b);
  auto rr=__builtin_amdgcn_permlane32_swap(__float_as_uint(m),__float_as_uint(m),false,false);
  return max2f(__uint_as_float(rr[0]),__uint_as_float(rr[1]));
}
__device__ __forceinline__ void pv(f32x16*o,int vb,bf16x8 pa0,bf16x8 pa1,bf16x8 pa2,bf16x8 pa3){
  #pragma unroll
  for(int d0=0;d0<2;++d0){s16x4 lo[4],hi[4];
    #pragma unroll
    for(int ks=0;ks<4;++ks){
      asm volatile("ds_read_b64_tr_b16 %0,%1 offset:%c2":"=&v"(lo[ks]):"v"(vb),"i"(d0*4096+ks*1024):"memory");
      asm volatile("ds_read_b64_tr_b16 %0,%1 offset:%c2":"=&v"(hi[ks]):"v"(vb),"i"(d0*4096+ks*1024+512):"memory");}
    asm volatile("s_waitcnt lgkmcnt(0)":::"memory");SBAR();
    #define PK(k) (bf16x8){lo[k][0],lo[k][1],lo[k][2],lo[k][3],hi[k][0],hi[k][1],hi[k][2],hi[k][3]}
    o[d0]=__builtin_amdgcn_mfma_f32_32x32x16_bf16(pa0,PK(0),o[d0],0,0,0);
    o[d0]=__builtin_amdgcn_mfma_f32_32x32x16_bf16(pa1,PK(1),o[d0],0,0,0);
    o[d0]=__builtin_amdgcn_mfma_f32_32x32x16_bf16(pa2,PK(2),o[d0],0,0,0);
    o[d0]=__builtin_amdgcn_mfma_f32_32x32x16_bf16(pa3,PK(3),o[d0],0,0,0);
    #undef PK
  }
}

#ifndef ATTN_STORE16
#define ATTN_STORE16(p,v) (*(u32x4*)(p)=(v))
#endif
template<int THRL,class TF,bool NEGM=true> __device__ __forceinline__ void attn_unit(const bf16*Qb,int QP,const bf16*__restrict__ Kh,const bf16*__restrict__ Vh,int KP,bf16*Ob,int OP,int NT,const TF&F,char*shm){
  int tid_=ktid(); asm volatile("":"+v"(tid_));
  const int tid=tid_,lane=tid&63,r32=lane&31,hi=lane>>5; const int wid=__builtin_amdgcn_readfirstlane(tid>>6);
  const bf16*Qw=Qb+(long)(wid*QBLK)*QP;
  const unsigned lds0=(unsigned)(uintptr_t)shm;
  float*wsf=(float*)(shm+LDS_WS)+wid*64;
  const bf16*ksrc=Kh+(long)lane*KP+wid*8;
  const bf16*vsrc=Vh+(long)(16*(wid&3)+(lane>>2))*KP+(wid>>2)*32+(lane&3)*8;
  const unsigned kdst=lds0+LDS_K+wid*1024, vdst=lds0+LDS_V+wid*1024;
  #define DMA_K(t,slot) glds16(ksrc+F.koff(t),(unsigned)__builtin_amdgcn_readfirstlane(kdst+(slot)))
  #define DMA_V(t,slot) glds16(vsrc+F.koff(t),(unsigned)__builtin_amdgcn_readfirstlane(vdst+(slot)))
  const int vb0=(int)(lds0+LDS_V)+((lane>>4)&1)*32+(lane&3)*8+(4*hi+((lane&15)>>2))*64;
  const char*Kbase=shm+LDS_K; bf16x8 kf[8];
  const lds_cptr shm3=(lds_cptr)shm; const lds_cptr kp0=shm3+LDS_K+hi*1024+r32*16; const lds_cptr vp0=shm3+LDS_V+((lane>>4)&1)*32+(lane&3)*8+(4*hi+((lane&15)>>2))*64;
  DMA_K(0,0);DMA_V(0,0);DMA_K(1,SLOTB);
  bf16x8 qr[4];
  #pragma unroll
  for(int d0=0;d0<4;++d0)qr[d0]=*reinterpret_cast<const bf16x8*>(&Qw[(long)r32*QP+d0*16+hi*8]);
  float mhat=0.f,l_reg=0.f;f32x16 o[2];o[0]=f32x16{};o[1]=f32x16{};f32x16 negm=f32x16{};if constexpr(NEGM)asm volatile("":"+v"(negm));
  const int qrel=wid*QBLK+r32;
  #define CMASK(P0,P1,t) F.mask(P0,P1,(t),qrel,hi)
  bool resc=false;
  #define START(P0,P1) do{ const float rm=rowmax(P0,P1); resc=false; \
    { const float dl=rm; mhat=fadd_s(mhat,dl); \
      _Pragma("unroll") for(int r=0;r<16;++r){P0[r]=fsub_s(P0[r],dl);P1[r]=fsub_s(P1[r],dl);} \
      if constexpr(NEGM){ _Pragma("unroll") for(int r=0;r<16;++r)negm[r]=-mhat; asm volatile("":"+v"(negm)); } } \
    _Pragma("unroll") for(int r=0;r<16;++r)P0[r]=__builtin_amdgcn_exp2f(P0[r]); }while(0)
  #define RESC() do{ if(resc){ asm volatile("s_waitcnt lgkmcnt(0)":::"memory"); \
      _Pragma("unroll") for(int d_=0;d_<2;++d_) _Pragma("unroll") for(int r=0;r<16;++r)o[d_][r]*=wsf[crow(r,hi)]; } }while(0)
  f32x16 pA0,pA1,pB0,pB1;
  int sl_prev=0,sl_cur=0,sl_next=SLOTB;
  #define ROT() do{sl_prev=sl_cur;sl_cur=sl_next;sl_next=(sl_next==(NSLOT-1)*SLOTB)?0:sl_next+SLOTB;}while(0)
  DMA_K(2,2*SLOTB);
  WAIT_BAR(3);
  qkt(pA0,pA1,Kbase,qr,negm,r32,hi);asm volatile("s_nop 15\n\ts_nop 7":"+v"(pA0),"+v"(pA1));CMASK(pA0,pA1,0);
  START(pA0,pA1);
  _Pragma("unroll") for(int r=0;r<16;++r)pA1[r]=__builtin_amdgcn_exp2f(pA1[r]);
  WAIT_BAR(0);
  DMA_K(3,0);DMA_V(1,SLOTB);
  ROT();
  kload8(kf,kp0+sl_cur);
  WAIT_BAR(2);
  s16x4 vlo[8],vhi[8]; u32x4 pw0,pw1,pw2,pw3;
  #define PKW(P,B) cvtpk_s(P[B],P[B+1])
  #define PAF(k) __builtin_bit_cast(bf16x8,pw##k)
  #define VFR(i) (bf16x8){vlo[i][0],vlo[i][1],vlo[i][2],vlo[i][3],vhi[i][0],vhi[i][1],vhi[i][2],vhi[i][3]}
  #define PIN(x) asm volatile("":"+v"(x))
  #define MX3(a,b,c) __builtin_fmaxf(__builtin_fmaxf((a),(b)),(c))
  #define GAPA(MF,A0,A1,A2,A3,W0,W1,PW) do{ MF; sacc+=A0; sacc+=A1; sacc+=A2; sacc+=A3; PIN(sacc); W0; W1; PIN(PW); SBAR(); }while(0)
  #define EX(v) __builtin_amdgcn_exp2f(v)
  #define GAPB(MF,X,B) do{ MF; X[B]=EX(X[B]); X[B+1]=EX(X[B+1]); X[B+2]=EX(X[B+2]); X[B+3]=EX(X[B+3]); PIN(X); SBAR(); }while(0)
  #define VRD(i) do{ vlo[i]=vtr(vp_+(((i)>>2)*4096+((i)&3)*1024)); vhi[i]=vtr(vp_+(((i)>>2)*4096+((i)&3)*1024+512)); }while(0)
  #define KRD(G,j) do{ if(G){ kload2(kf,kp0+sl_next,j); SBAR(); } }while(0)
  #define STEP(C0,C1,P0,P1,t,GK,GV,GL) do{ SBAR(); \
    const lds_cptr vp_=vp0+sl_prev; \
    VRD(0); SBAR(); float sacc=(P0[0]+P0[1]); \
    GAPA(C0=__builtin_amdgcn_mfma_f32_32x32x16_bf16(kf[0],qr[0],(NEGM?negm:f32x16{}),0,0,0), P0[2],P0[3],P0[4],P0[5],     pw0[0]=PKW(P0,0), pw0[1]=PKW(P0,2), pw0); \
    VRD(4); SBAR(); GAPA(C1=__builtin_amdgcn_mfma_f32_32x32x16_bf16(kf[1],qr[0],(NEGM?negm:f32x16{}),0,0,0), P0[6],P0[7],P0[8],P0[9],     pw0[2]=PKW(P0,4), pw0[3]=PKW(P0,6), pw0); \
    VRD(1); SBAR(); GAPA(C0=__builtin_amdgcn_mfma_f32_32x32x16_bf16(kf[2],qr[1],C0,0,0,0),   P0[10],P0[11],P0[12],P0[13], pw1[0]=PKW(P0,8), pw1[1]=PKW(P0,10), pw1); \
    VRD(5); SBAR(); GAPA(C1=__builtin_amdgcn_mfma_f32_32x32x16_bf16(kf[3],qr[1],C1,0,0,0),   P0[14],P0[15],P1[0],P1[1],   pw1[2]=PKW(P0,12),pw1[3]=PKW(P0,14), pw1); \
    VRD(2); SBAR(); GAPA(C0=__builtin_amdgcn_mfma_f32_32x32x16_bf16(kf[4],qr[2],C0,0,0,0),   P1[2],P1[3],P1[4],P1[5],     pw2[0]=PKW(P1,0), pw2[1]=PKW(P1,2), pw2); \
    VRD(6); SBAR(); GAPA(C1=__builtin_amdgcn_mfma_f32_32x32x16_bf16(kf[5],qr[2],C1,0,0,0),   P1[6],P1[7],P1[8],P1[9],     pw2[2]=PKW(P1,4), pw2[3]=PKW(P1,6), pw2); \
    VRD(3); SBAR(); GAPA(C0=__builtin_amdgcn_mfma_f32_32x32x16_bf16(kf[6],qr[3],C0,0,0,0),   P1[10],P1[11],P1[12],P1[13], pw3[0]=PKW(P1,8), pw3[1]=PKW(P1,10), pw3); \
    VRD(7); SBAR(); GAPA(C1=__builtin_amdgcn_mfma_f32_32x32x16_bf16(kf[7],qr[3],C1,0,0,0),   P1[14],P1[15],0.f,0.f,       pw3[2]=PKW(P1,12),pw3[3]=PKW(P1,14), pw3); \
    l_reg+=sacc; \
    if(GK){DMA_K((t)+3,sl_cur);} if(GV){DMA_V((t)+1,sl_next);} \
    if constexpr(!NEGM){ _Pragma("unroll") for(int r=0;r<16;++r){C0[r]-=mhat;C1[r]-=mhat;} } \
    CMASK(C0,C1,t); \
    { float a=MX3(C0[0],C0[1],C1[0]),b=MX3(C0[2],C0[3],C1[1]); a=MX3(a,C1[2],C1[3]); \
      _Pragma("unroll") for(int r=4;r<16;r+=4){a=MX3(a,C0[r],C0[r+1]);b=MX3(b,C0[r+2],C0[r+3]);a=MX3(a,C1[r],C1[r+1]);b=MX3(b,C1[r+2],C1[r+3]);} \
      float rm=__builtin_fmaxf(a,b); { auto rr=__builtin_amdgcn_permlane32_swap(__float_as_uint(rm),__float_as_uint(rm),false,false); rm=__builtin_fmaxf(__uint_as_float(rr[0]),__uint_as_float(rr[1])); } \
      resc=false; \
      if(__builtin_expect(__any(rm>(float)THRL),0)){ const float dl=__builtin_fmaxf(rm,0.f); mhat+=dl; \
        _Pragma("unroll") for(int r=0;r<16;++r){C0[r]-=dl;C1[r]-=dl;} \
        if constexpr(NEGM){ _Pragma("unroll") for(int r=0;r<16;++r)negm[r]=-mhat; asm volatile("":"+v"(negm)); } \
        const float f=__builtin_amdgcn_exp2f(-dl); l_reg*=f; if(hi==0)wsf[r32]=f; resc=true; } } \
    SBAR(); \
    GAPB(o[0]=__builtin_amdgcn_mfma_f32_32x32x16_bf16(PAF(0),VFR(0),o[0],0,0,0), C0,0); \
    GAPB(o[1]=__builtin_amdgcn_mfma_f32_32x32x16_bf16(PAF(0),VFR(4),o[1],0,0,0), C0,4); \
    KRD(GL,0); GAPB(o[0]=__builtin_amdgcn_mfma_f32_32x32x16_bf16(PAF(1),VFR(1),o[0],0,0,0), C0,8); \
    KRD(GL,1); GAPB(o[1]=__builtin_amdgcn_mfma_f32_32x32x16_bf16(PAF(1),VFR(5),o[1],0,0,0), C0,12); \
    KRD(GL,2); GAPB(o[0]=__builtin_amdgcn_mfma_f32_32x32x16_bf16(PAF(2),VFR(2),o[0],0,0,0), C1,0); \
    KRD(GL,3); GAPB(o[1]=__builtin_amdgcn_mfma_f32_32x32x16_bf16(PAF(2),VFR(6),o[1],0,0,0), C1,4); \
    GAPB(o[0]=__builtin_amdgcn_mfma_f32_32x32x16_bf16(PAF(3),VFR(3),o[0],0,0,0), C1,8); \
    GAPB(o[1]=__builtin_amdgcn_mfma_f32_32x32x16_bf16(PAF(3),VFR(7),o[1],0,0,0), C1,12); \
    }while(0)
  int t=1;
  for(;t+5<NT;t+=2){
    STEP(pB0,pB1,pA0,pA1,t,true,true,true);     WAIT_BAR(2); RESC(); ROT();
    STEP(pA0,pA1,pB0,pB1,t+1,true,true,true);   WAIT_BAR(2); RESC(); ROT();
  }
  #undef CMASK
  #define CMASK(P0,P1,t) F.mask(P0,P1,(t),qrel,hi)
  #define ENDW(tt) do{ if((tt)+3<NT){WAIT_BAR(2);} else if((tt)+2<NT){WAIT_BAR(1);} else {WAIT_BAR(0);} }while(0)
  for(;t+1<NT;t+=2){
    STEP(pB0,pB1,pA0,pA1,t,(t+3<NT),(t+1<NT),(t+1<NT));       ENDW(t);   RESC(); ROT();
    STEP(pA0,pA1,pB0,pB1,t+1,(t+4<NT),(t+2<NT),(t+2<NT));     ENDW(t+1); RESC(); ROT();
  }
  STEP(pB0,pB1,pA0,pA1,NT-1,false,false,false); RESC();
  { float sacc=pB0[0]+pB0[1]; _Pragma("unroll") for(int r=2;r<16;++r)sacc+=pB0[r]; _Pragma("unroll") for(int r=0;r<16;++r)sacc+=pB1[r]; l_reg+=sacc;
    pw0=(u32x4){PKW(pB0,0),PKW(pB0,2),PKW(pB0,4),PKW(pB0,6)};pw1=(u32x4){PKW(pB0,8),PKW(pB0,10),PKW(pB0,12),PKW(pB0,14)};pw2=(u32x4){PKW(pB1,0),PKW(pB1,2),PKW(pB1,4),PKW(pB1,6)};pw3=(u32x4){PKW(pB1,8),PKW(pB1,10),PKW(pB1,12),PKW(pB1,14)};
    SBAR(); pv(o,vb0+sl_cur,PAF(0),PAF(1),PAF(2),PAF(3)); }
  #undef PKW
  #undef PAF
  #undef VFR
  #undef PIN
  #undef MX3
  #undef GAPA
  #undef GAPB
  #undef EX
  #undef VRD
  #undef KRD
  #undef STEP
  #undef ENDW
  {auto rr=__builtin_amdgcn_permlane32_swap(__float_as_uint(l_reg),__float_as_uint(l_reg),false,false);l_reg=__uint_as_float(rr[0])+__uint_as_float(rr[1]);}
  if(hi==0)wsf[32+r32]=l_reg;asm volatile("s_waitcnt lgkmcnt(0)":::"memory");
  float rli[16];
  #pragma unroll
  for(int r=0;r<16;++r)rli[r]=__builtin_amdgcn_rcpf(wsf[32+crow(r,hi)]);
  bf16*Ow=Ob+(long)(wid*QBLK)*OP;
  { bf16*stg=(bf16*)(shm+LDS_OST)+wid*2048;
    #pragma unroll
    for(int r=0;r<16;++r){const int orow=crow(r,hi);
      #pragma unroll
      for(int d0=0;d0<2;++d0)stg[orow*64+d0*32+r32]=__float2bfloat16(o[d0][r]*rli[r]);}
    asm volatile("s_waitcnt lgkmcnt(0)":::"memory");
    #pragma unroll
    for(int i=0;i<4;++i){const int row=i*8+(lane>>3),ch=lane&7; const u32x4 v=*(const u32x4*)(stg+row*64+ch*8); ATTN_STORE16(Ow+(long)row*OP+ch*8,v);} }
  asm volatile("s_waitcnt lgkmcnt(0)\n\ts_barrier":::"memory");
  #undef DMA_K
  #undef DMA_V
  #undef CMASK
  #undef START
  #undef RESC
  #undef ROT
}
constexpr int ATTN_LDS_BYTES=LDS_BYTES;
#undef SBAR
#undef WAIT_BAR
}
struct DenseTF { long kstep; __device__ __forceinline__ long koff(int t) const { return (long)t * kstep; }
    __device__ __forceinline__ void mask(attn_body::f32x16&, attn_body::f32x16&, int, int, int) const {} };
constexpr int ATT_NBIG = BATCH * A_HEADS * (SEQ / 256), ATT_NSMALL = 2 * BATCH * A_HEADS;
static_assert(KVLEN % 128 == 0 && CTX_LEN == 256 && HD == 64 && A_HEADS == B_HEADS, "attention unit geometry");
__device__ __forceinline__ int claim_unit(unsigned* ctr, char* lds) {
    volatile __attribute__((address_space(3))) unsigned* w = (volatile __attribute__((address_space(3))) unsigned*)((__attribute__((address_space(3))) char*)lds + 131072 + 128);
    if (ktid() == 0) w[0] = __hip_atomic_fetch_add(ctr, 1u, __ATOMIC_RELAXED, __HIP_MEMORY_SCOPE_AGENT);
    __syncthreads(); const unsigned u = w[0]; __syncthreads();
    return (int)u;
}
__device__ __forceinline__ void attn_phase_dense(unsigned char* wsb, unsigned* ctr, int nunits, char* lds, int G, int c) {
    using attn_body::bf16;
    const bf16* KBc = (const bf16*)(ws_at(wsb, WSO.XS)); const bf16* VBc = (const bf16*)(ws_at(wsb, WSO.XS + KVB_BYTES));
    bf16* QA = (bf16*)(ws_at(wsb, WSO.QA)); bf16* KA = (bf16*)(ws_at(wsb, WSO.KA)); bf16* VA = (bf16*)(ws_at(wsb, WSO.VA)); bf16* OA = (bf16*)(ws_at(wsb, WSO.OA)); bf16* OB = (bf16*)(ws_at(wsb, WSO.OB)); bf16* Z = (bf16*)(ws_at(wsb, WSO.Z));
    for (;;) { const int uu = claim_unit(ctr, lds); if (uu >= nunits) break;
        const bf16 *Qb, *Kh, *Vh; bf16* Ob; int QP, KP, NT;
        if (uu < ATT_NBIG) { const int u = uu;
            const int qb = u % (SEQ / 256), h = (u / (SEQ / 256)) % A_HEADS, b = u / (SEQ / 256 * A_HEADS), kvh = h / (A_HEADS / A_KV_HEADS);
            const size_t qrow = (size_t)b * SEQ + (size_t)qb * 256;
            Qb = QA + qrow * A_Q_W + h * HD; Ob = OA + qrow * BRANCH_W + h * HD; QP = A_Q_W;
            Kh = KA + (size_t)b * KVLEN * A_KV_W + kvh * HD; Vh = VA + (size_t)b * KVLEN * A_KV_W + kvh * HD; KP = A_KV_W; NT = KVLEN / 64;
        } else { const int u = uu - ATT_NBIG;
            const int h = u % A_HEADS, b = (u / A_HEADS) % BATCH, kind = u / (A_HEADS * BATCH); const size_t qrow = (size_t)NLAT + (size_t)b * CTX_LEN; NT = CTX_LEN / 64;
            if (kind == 0) { const int kvh = h / (A_HEADS / A_KV_HEADS); Qb = QA + qrow * A_Q_W + h * HD; Ob = OA + qrow * BRANCH_W + h * HD; QP = A_Q_W;
                Kh = KA + ((size_t)b * KVLEN + SEQ) * A_KV_W + kvh * HD; Vh = VA + ((size_t)b * KVLEN + SEQ) * A_KV_W + kvh * HD; KP = A_KV_W; }
            else { Qb = Z + qrow * ZN + ZC_QB + h * HD; Ob = OB + qrow * BRANCH_W + h * HD; QP = ZN; Kh = KBc + ((size_t)(b * B_HEADS + h) * KVLEN + SEQ) * HD; Vh = VBc + ((size_t)(b * B_HEADS + h) * KVLEN + SEQ) * HD; KP = HD; }
        }
        const DenseTF F{(long)64 * KP};
        attn_body::attn_unit<8>(Qb, QP, Kh, Vh, KP, Ob, BRANCH_W, NT, F, lds);
    }
}


constexpr int NA_TAB_OFF = 86016, NA_TAB_N = (2 * NA_ROWS - 1) * (2 * NA_COLS - 1);
static_assert(NA_TAB_OFF >= attn_body::ATTN_LDS_BYTES && NA_TAB_OFF + 4096 <= 131072 && GRID_W == 64 && NA_ROWS == 8 && NA_COLS == 16 && GRID_H >= 16, "neighbourhood geometry");
struct NaTF { long ctx_off0, lat_off0; int kr_lo, nwin, r0; const __attribute__((address_space(3))) float* tab;
    __device__ __forceinline__ long koff(int t) const { const int w_ = t - 4; return t < 4 ? ctx_off0 + (long)t * 64 * HD : lat_off0 + (long)(w_ < nwin ? w_ : nwin - 1) * 64 * HD; }
    __device__ __forceinline__ void mask(attn_body::f32x16& p0, attn_body::f32x16& p1, int t, int qrel, int hi) const {
        if (t < 4) return;
        const int kr = kr_lo + (t - 4), qr = r0 + (qrel >> 6), qc = qrel & 63;
        const int rs = min(max(qr - NA_ROWS / 2, 0), GRID_H - NA_ROWS), cs = min(max(qc - NA_COLS / 2, 0), GRID_W - NA_COLS);
        const bool rowok = (unsigned)(kr - rs) < (unsigned)NA_ROWS;
        const int ri = min(max(kr - qr + NA_ROWS - 1, 0), 2 * NA_ROWS - 2);
        const __attribute__((address_space(3))) float* tb = tab + ri * (2 * NA_COLS - 1) + (4 * hi - qc + NA_COLS - 1);
        const int off = rowok ? 4 * hi - cs : 0x40000000;
#pragma unroll
        for (int r = 0; r < 16; ++r) { const int kc0 = (r & 3) + 8 * (r >> 2);
            p0[r] = (unsigned)(kc0 + off) < (unsigned)NA_COLS ? p0[r] + tb[kc0] : -INFINITY;
            p1[r] = (unsigned)(kc0 + 32 + off) < (unsigned)NA_COLS ? p1[r] + tb[kc0 + 32] : -INFINITY; }
    } };
constexpr int NA_UNITS = BATCH * B_HEADS * (GRID_H / 4);
constexpr int NA_GROUPS = BATCH * B_HEADS, NA_LOCAL_G = 6, NA_PER_G = GRID_H / 4;
static_assert(NA_GROUPS % 8 == 0 && NA_GROUPS / 8 > NA_LOCAL_G, "neighbourhood-attention unit placement");
__device__ __forceinline__ void attn_phase_na(unsigned char* wsb, const float* rpb_l, unsigned* ctr, int xcc, char* lds, int G, int c) {
    using attn_body::bf16;
    bf16* Z = (bf16*)(ws_at(wsb, WSO.Z)); bf16* OB = (bf16*)(ws_at(wsb, WSO.OB)); const bf16* KBc = (const bf16*)(ws_at(wsb, WSO.XS)); const bf16* VBc = (const bf16*)(ws_at(wsb, WSO.XS + KVB_BYTES));
    __attribute__((address_space(3))) float* tab = (__attribute__((address_space(3))) float*)((__attribute__((address_space(3))) char*)lds + NA_TAB_OFF);
    int pass = 0, xq = xcc & 7;
    for (;;) {
        if (pass == 2) { volatile __attribute__((address_space(3))) int* wq = (volatile __attribute__((address_space(3))) int*)((__attribute__((address_space(3))) char*)lds + 131072 + 128);
            if (ktid() == 0) { unsigned v_[8]; int f_ = -1;
#pragma unroll
                for (int x = 0; x < 8; ++x) v_[x] = __hip_atomic_load(ctr + 8 * x, __ATOMIC_RELAXED, __HIP_MEMORY_SCOPE_AGENT);
#pragma unroll
                for (int x = 7; x >= 0; --x) if (v_[x] < (unsigned)(NA_LOCAL_G * NA_PER_G)) f_ = x;
                wq[0] = f_; }
            __syncthreads(); const int f = wq[0]; __syncthreads();
            if (f < 0) break; xq = f; }
        const int q = claim_unit(ctr + 8 * (pass == 1 ? 8 : xq), lds);
        if (q >= (pass == 1 ? (NA_GROUPS / 8 - NA_LOCAL_G) * 8 * NA_PER_G : NA_LOCAL_G * NA_PER_G)) { if (pass < 2) ++pass; continue; }
        const int gq = q / NA_PER_G, rb = q % NA_PER_G;
        const int grp = pass == 1 ? (gq % 8) + 8 * (NA_LOCAL_G + gq / 8) : xq + 8 * gq;
        const int h = grp % B_HEADS, b = grp / B_HEADS, r0 = rb * 4;
        const int kr_lo = min(max(r0 - NA_ROWS / 2, 0), GRID_H - NA_ROWS), kr_hi = min(max(r0 + 3 - NA_ROWS / 2, 0), GRID_H - NA_ROWS) + NA_ROWS - 1, nwin = kr_hi - kr_lo + 1;
        int tid_ = ktid(); asm volatile("" : "+v"(tid_));
        for (int i = tid_; i < NA_TAB_N; i += 512) tab[i] = rpb_l[(size_t)h * NA_TAB_N + i] * LOG2E;
        const size_t qrow = (size_t)b * SEQ + (size_t)r0 * GRID_W;
        const NaTF F{(long)SEQ * HD, (long)kr_lo * GRID_W * HD, kr_lo, nwin, r0, tab};
        const size_t kvb = (size_t)(b * B_HEADS + h) * KVLEN * HD;
        attn_body::attn_unit<8, NaTF, false>(Z + qrow * ZN + ZC_QB + h * HD, ZN, KBc + kvb, VBc + kvb, HD, OB + qrow * BRANCH_W + h * HD, BRANCH_W, (4 + nwin + 1) & ~1, F, lds);
    }
}

namespace gdn {
#define GLAS __attribute__((address_space(3)))
typedef short bf16x8 __attribute__((ext_vector_type(8)));
typedef float f32x16 __attribute__((ext_vector_type(16)));
typedef float f32x4 __attribute__((ext_vector_type(4)));
typedef unsigned u32x4 __attribute__((ext_vector_type(4)));
typedef unsigned u32x2 __attribute__((ext_vector_type(2)));
constexpr int NCH = KVLEN / 64, NCHAIN = 2 * BATCH * C_HEADS, FRAGS = 41, CHUNK_BYTES = FRAGS * 1024, NCTXCH = CTX_LEN / 64;
static_assert(HD == 64 && CTX_LEN % 64 == 0 && SEQ % 64 == 0 && 3 * CHUNK_BYTES <= 131072 && NCH >= 2, "chunk geometry");
typedef float f32x2_t __attribute__((ext_vector_type(2))); typedef __bf16 bf16x2_t __attribute__((ext_vector_type(2)));
__device__ __forceinline__ unsigned pk(float lo, float hi) { const f32x2_t v = {lo, hi}; return __builtin_bit_cast(unsigned, __builtin_convertvector(v, bf16x2_t)); }
__device__ __forceinline__ float blo(unsigned u) { return __uint_as_float(u << 16); }
__device__ __forceinline__ float bhi(unsigned u) { return __uint_as_float(u & 0xffff0000u); }
__device__ __forceinline__ int smat(int i, int j) { return i * 128 + ((((j >> 3) ^ i) & 7) << 4) + ((j & 7) << 1); }
__device__ __forceinline__ int chunk_row(int dir, int b, int ci, int p) {
    const bool cx = ci < NCTXCH; const int len = cx ? CTX_LEN : SEQ, cl = cx ? ci : ci - NCTXCH, base = cx ? NLAT + b * CTX_LEN : b * SEQ, t = cl * 64 + p;
    return base + (dir ? len - 1 - t : t);
}
__device__ __forceinline__ bf16x8 asfrag(u32x4 v) { return __builtin_bit_cast(bf16x8, v); }
#define GDN_FENCE() asm volatile("" ::: "memory")

__device__ __forceinline__ void intra_unit(unsigned char* wsb, int chain, int ci, GLAS unsigned char* L, int lane0) {
    const int h = chain % C_HEADS, b = (chain / C_HEADS) % BATCH, dir = chain / (C_HEADS * BATCH);
    const bf16_t* QC = (const bf16_t*)(ws_at(wsb, WSO.QC)) + h * HD; const bf16_t* KC = (const bf16_t*)(ws_at(wsb, WSO.KC)) + h * HD; const bf16_t* VC = (const bf16_t*)(ws_at(wsb, WSO.VC)) + h * HD;
    unsigned char* gop = ws_at(wsb, WSO.GOP) + ((size_t)chain * NCH + ci) * CHUNK_BYTES;
    GLAS unsigned char* R1 = L + 8192;
#define GDN_STAGE int ln_ = lane0; asm volatile("" : "+v"(ln_)); const int lane = ln_, m31 = ln_ & 31, hh = ln_ >> 5; (void)lane; (void)m31; (void)hh; \
    const size_t myrow = (size_t)chunk_row(dir, b, ci, lane); (void)myrow; \
    const size_t frow[2] = {(size_t)chunk_row(dir, b, ci, m31) * C_W + 8 * hh, (size_t)chunk_row(dir, b, ci, 32 + m31) * C_W + 8 * hh}; (void)frow; \
    int tb[8]; _Pragma("unroll") for (int x = 0; x < 8; ++x) tb[x] = x * 128 + ((((lane >> 3) ^ x) & 7) << 4) + ((lane & 7) << 1); (void)tb;
#define GDN_TRANSPOSE_IN(X, sc) do { _Pragma("unroll") for (int y = 0; y < 8; ++y) { const u32x4 v = *(const u32x4*)((X) + myrow * C_W + 8 * y); \
        _Pragma("unroll") for (int e = 0; e < 4; ++e) { const unsigned wv = v[e]; const unsigned two = pk(blo(wv) * (sc), bhi(wv) * (sc)); \
            *(GLAS unsigned short*)(R1 + tb[2 * e] + 1024 * y) = (unsigned short)(two & 0xffffu); *(GLAS unsigned short*)(R1 + tb[2 * e + 1] + 1024 * y) = (unsigned short)(two >> 16); } } } while (0)
#define GDN_AFRAG(mat, row, ks) ({ const u32x2 p0_ = *(const GLAS u32x2*)((mat) + smat((row), 16 * (ks) + 4 * hh)), p1_ = *(const GLAS u32x2*)((mat) + smat((row), 16 * (ks) + 8 + 4 * hh)); (u32x4){p0_.x, p0_.y, p1_.x, p1_.y}; })
#define GDN_EMIT(fbase, mat) do { _Pragma("unroll") for (int a = 0; a < 2; ++a) _Pragma("unroll") for (int ks = 0; ks < 4; ++ks) \
        __builtin_nontemporal_store(GDN_AFRAG(mat, 32 * a + m31, ks), (u32x4*)(gop + (size_t)((fbase) + a * 4 + ks) * 1024 + lane * 16)); } while (0)
    float gc, be, eg, ek;
    f32x16 Lr[3];
    { GDN_STAGE
      be = ((const float*)(ws_at(wsb, WSO.BETA)))[(myrow * 2 + dir) * C_HEADS + h];
      gc = ((const float*)(ws_at(wsb, WSO.G)))[(myrow * 2 + dir) * C_HEADS + h];
#pragma unroll
      for (int o = 1; o < 64; o <<= 1) { const float t = shf_idx(gc, lane - o); if (lane >= o) gc += t; }
      const float glast = shf_idx(gc, 63); eg = __expf(gc); ek = __expf(glast - gc);
      *(float*)(gop + 40 * 1024 + lane * 16) = __expf(glast);
      bf16x8 kf[2][4];
#pragma unroll
      for (int t = 0; t < 2; ++t)
#pragma unroll
        for (int s = 0; s < 4; ++s) kf[t][s] = *(const bf16x8*)(KC + frow[t] + 16 * s);
#pragma unroll
      for (int tt = 0; tt < 3; ++tt) { const int ti = tt == 0 ? 0 : 1, tj = tt == 2 ? 1 : 0;
        f32x16 acc = {};
#pragma unroll
        for (int s = 0; s < 4; ++s) acc = __builtin_amdgcn_mfma_f32_32x32x16_bf16(kf[ti][s], kf[tj][s], acc, 0, 0, 0);
        const int j = 32 * tj + m31; const float gj = shf_idx(gc, j);
#pragma unroll
        for (int g4 = 0; g4 < 4; ++g4)
#pragma unroll
            for (int e = 0; e < 4; ++e) { const int i = 32 * ti + e + 8 * g4 + 4 * hh; const float gi = shf_idx(gc, i), bi = shf_idx(be, i); Lr[tt][4 * g4 + e] = i > j ? bi * acc[4 * g4 + e] * __expf(gi - gj) : 0.f; }
      }
    }
    GDN_FENCE();
    { GDN_STAGE
      float T[64];
#pragma unroll
      for (int j = 0; j < 64; ++j) T[j] = 0.f;
      T[63] = lane == 63 ? 1.f : 0.f;
#pragma unroll
      for (int j = 62; j >= 0; --j) { float a0 = 0.f, a1 = 0.f, a2 = 0.f, a3 = 0.f;
#pragma unroll
        for (int i = j + 1; i < 64; ++i) { const float lij = __int_as_float(__builtin_amdgcn_readlane(__float_as_int(Lr[(i >> 5) + (j >> 5)][(i & 3) + 4 * ((i & 31) >> 3)]), (j & 31) + 32 * (((i & 31) >> 2) & 1)));
            if ((i & 3) == 0) a0 += T[i] * lij; else if ((i & 3) == 1) a1 += T[i] * lij; else if ((i & 3) == 2) a2 += T[i] * lij; else a3 += T[i] * lij; }
        int lj_ = lane; asm volatile("" : "+v"(lj_)); T[j] = (lj_ == j ? 1.f : 0.f) - ((a0 + a1) + (a2 + a3)); }
      GDN_FENCE();
#pragma unroll
      for (int ch = 0; ch < 8; ++ch) { u32x4 o; o.x = pk(T[8 * ch], T[8 * ch + 1]); o.y = pk(T[8 * ch + 2], T[8 * ch + 3]); o.z = pk(T[8 * ch + 4], T[8 * ch + 5]); o.w = pk(T[8 * ch + 6], T[8 * ch + 7]);
        *(GLAS u32x4*)(L + smat(lane, 8 * ch)) = o; }
    }
    GDN_FENCE();
    { GDN_STAGE const float sc = be * eg; GDN_TRANSPOSE_IN(KC, sc); }
    GDN_FENCE();
    { GDN_STAGE
      bf16x8 af[2][4], bfr[2][4];
#pragma unroll
      for (int a = 0; a < 2; ++a)
#pragma unroll
        for (int s = 0; s < 4; ++s) { af[a][s] = *(const GLAS bf16x8*)(R1 + smat(32 * a + m31, 16 * s + 8 * hh)); bfr[a][s] = *(const GLAS bf16x8*)(L + smat(32 * a + m31, 16 * s + 8 * hh)); }
      f32x16 acc[2][2];
#pragma unroll
      for (int a = 0; a < 2; ++a)
#pragma unroll
        for (int bb = 0; bb < 2; ++bb) { acc[a][bb] = (f32x16){};
#pragma unroll
            for (int s = 0; s < 4; ++s) acc[a][bb] = __builtin_amdgcn_mfma_f32_32x32x16_bf16(af[a][s], bfr[bb][s], acc[a][bb], 0, 0, 0); }
      GDN_FENCE();
#pragma unroll
      for (int a = 0; a < 2; ++a)
#pragma unroll
        for (int bb = 0; bb < 2; ++bb)
#pragma unroll
            for (int g4 = 0; g4 < 4; ++g4) { u32x2 o; o.x = pk(-acc[a][bb][4 * g4], -acc[a][bb][4 * g4 + 1]); o.y = pk(-acc[a][bb][4 * g4 + 2], -acc[a][bb][4 * g4 + 3]);
                *(GLAS u32x2*)(R1 + smat(32 * bb + m31, 32 * a + 8 * g4 + 4 * hh)) = o; }
      GDN_FENCE();
      GDN_EMIT(0, R1);
    }
    GDN_FENCE();
    { GDN_STAGE GDN_TRANSPOSE_IN(VC, be); }
    GDN_FENCE();
    { GDN_STAGE
      bf16x8 af[2][4], bfr[2][4];
#pragma unroll
      for (int a = 0; a < 2; ++a)
#pragma unroll
        for (int s = 0; s < 4; ++s) { af[a][s] = *(const GLAS bf16x8*)(L + smat(32 * a + m31, 16 * s + 8 * hh)); bfr[a][s] = *(const GLAS bf16x8*)(R1 + smat(32 * a + m31, 16 * s + 8 * hh)); }
#pragma unroll
      for (int bb = 0; bb < 2; ++bb)
#pragma unroll
        for (int a = 0; a < 2; ++a) { f32x16 acc = {};
#pragma unroll
            for (int s = 0; s < 4; ++s) acc = __builtin_amdgcn_mfma_f32_32x32x16_bf16(af[a][s], bfr[bb][s], acc, 0, 0, 0);
#pragma unroll
            for (int part = 0; part < 2; ++part) { u32x4 o; o.x = pk(acc[8 * part], acc[8 * part + 1]); o.y = pk(acc[8 * part + 2], acc[8 * part + 3]); o.z = pk(acc[8 * part + 4], acc[8 * part + 5]); o.w = pk(acc[8 * part + 6], acc[8 * part + 7]);
                __builtin_nontemporal_store(o, (u32x4*)(gop + (size_t)(32 + (bb * 2 + a) * 2 + part) * 1024 + lane * 16)); } }
    }
    GDN_FENCE();
    { GDN_STAGE
#pragma unroll
      for (int ch = 0; ch < 8; ++ch) { const u32x4 v = *(const u32x4*)(QC + myrow * C_W + 8 * ch); u32x4 o;
#pragma unroll
        for (int e = 0; e < 4; ++e) o[e] = pk(blo(v[e]) * eg, bhi(v[e]) * eg);
        *(GLAS u32x4*)(L + smat(lane, 8 * ch)) = o; }
      GDN_TRANSPOSE_IN(KC, ek);
      GDN_FENCE();
      GDN_EMIT(8, L); GDN_EMIT(24, R1);
    }
    GDN_FENCE();
    { GDN_STAGE
      bf16x8 qf[2][4], kf[2][4];
#pragma unroll
      for (int t = 0; t < 2; ++t)
#pragma unroll
        for (int s = 0; s < 4; ++s) { qf[t][s] = *(const bf16x8*)(QC + frow[t] + 16 * s); kf[t][s] = *(const bf16x8*)(KC + frow[t] + 16 * s); }
#pragma unroll
      for (int tj = 0; tj < 2; ++tj)
#pragma unroll
        for (int ti = 0; ti < 2; ++ti) { f32x16 acc = {};
            if (ti >= tj) {
#pragma unroll
                for (int s = 0; s < 4; ++s) acc = __builtin_amdgcn_mfma_f32_32x32x16_bf16(kf[tj][s], qf[ti][s], acc, 0, 0, 0); }
            const int i = 32 * ti + m31; const float gi = shf_idx(gc, i);
#pragma unroll
            for (int g4 = 0; g4 < 4; ++g4) { float v[4];
#pragma unroll
                for (int e = 0; e < 4; ++e) { const int j = 32 * tj + e + 8 * g4 + 4 * hh; const float gj = shf_idx(gc, j); v[e] = i >= j ? acc[4 * g4 + e] * __expf(gi - gj) : 0.f; }
                u32x2 o; o.x = pk(v[0], v[1]); o.y = pk(v[2], v[3]); *(GLAS u32x2*)(L + smat(i, 32 * tj + 8 * g4 + 4 * hh)) = o; } }
      GDN_FENCE();
      GDN_EMIT(16, L);
    }
    GDN_FENCE();
#undef GDN_STAGE
#undef GDN_TRANSPOSE_IN
#undef GDN_AFRAG
#undef GDN_EMIT
}
__device__ __forceinline__ void intra_phase(unsigned char* wsb, char* lds, int G, int c) {
    int tid_ = ktid(); asm volatile("" : "+v"(tid_));
    const int lane = tid_ & 63, wid = __builtin_amdgcn_readfirstlane(tid_ >> 6);
    GLAS unsigned char* L = (GLAS unsigned char*)lds + wid * 16384;
    const int U = NCHAIN * NCH, W = G * 8, full = U / W * W, remw = (U - full + G - 1) / G;
    for (int u = c * 8 + wid; u < full; u += W) intra_unit(wsb, u / NCH, u % NCH, L, lane);
    if (wid < remw) { const int u = full + wid * G + c; if (u < U) intra_unit(wsb, u / NCH, u % NCH, L, lane); }
}

__device__ __forceinline__ void scan_chain(unsigned char* wsb, int chain, char* lds) {
    int tid_ = ktid(); asm volatile("" : "+v"(tid_));
    const int lane = tid_ & 63, wid = __builtin_amdgcn_readfirstlane(tid_ >> 6), m31 = lane & 31, hh = lane >> 5;
    const int h = chain % C_HEADS, b = (chain / C_HEADS) % BATCH, dir = chain / (C_HEADS * BATCH);
    const unsigned char* gop = ws_at(wsb, WSO.GOP) + (size_t)chain * NCH * CHUNK_BYTES + lane * 16;
    float* obase = (float*)ws_at(wsb, WSO.OCD); const int ocol = h * HD + 32 * wid + m31;
    const unsigned lds0 = (unsigned)(uintptr_t)lds;
#define GDN_DMA(cc) do { if (wid >= 2) for (int f = wid - 2; f < FRAGS; f += 6) attn_body::glds16(gop + ((size_t)(cc) * FRAGS + f) * 1024, (unsigned)__builtin_amdgcn_readfirstlane(lds0 + ((cc) % 3) * CHUNK_BYTES + f * 1024)); } while (0)
    GDN_DMA(0); GDN_DMA(1);
    f32x16 s0 = {}, s1 = {};
    for (int cc = 0; cc < NCH; ++cc) {
        if (wid >= 2) { if (cc + 1 < NCH) asm volatile("s_waitcnt vmcnt(6)" ::: "memory"); else asm volatile("s_waitcnt vmcnt(0)" ::: "memory"); }
        asm volatile("s_waitcnt lgkmcnt(0)\n\ts_barrier" ::: "memory");
        if (cc + 2 < NCH) GDN_DMA(cc + 2);
        if (wid < 2) {
            const GLAS unsigned char* B = (const GLAS unsigned char*)lds + (cc % 3) * CHUNK_BYTES + lane * 16;
#define FR(f) (*(const GLAS bf16x8*)(B + (f) * 1024))
#define PK8(t, o) asfrag((u32x4){pk(t[o], t[o + 1]), pk(t[o + 2], t[o + 3]), pk(t[o + 4], t[o + 5]), pk(t[o + 6], t[o + 7])})
            const float sd = *(const GLAS float*)(B + 40 * 1024);
            const bf16x8 sB[4] = {PK8(s0, 0), PK8(s0, 8), PK8(s1, 0), PK8(s1, 8)};
            f32x16 vn[2];
#pragma unroll
            for (int a = 0; a < 2; ++a) { const u32x4 lo = *(const GLAS u32x4*)(B + (32 + (wid * 2 + a) * 2) * 1024), hi = *(const GLAS u32x4*)(B + (32 + (wid * 2 + a) * 2 + 1) * 1024);
#pragma unroll
                for (int e = 0; e < 4; ++e) { vn[a][2 * e] = blo(lo[e]); vn[a][2 * e + 1] = bhi(lo[e]); vn[a][8 + 2 * e] = blo(hi[e]); vn[a][8 + 2 * e + 1] = bhi(hi[e]); }
#pragma unroll
                for (int ks = 0; ks < 4; ++ks) vn[a] = __builtin_amdgcn_mfma_f32_32x32x16_bf16(FR(a * 4 + ks), sB[ks], vn[a], 0, 0, 0); }
            const bf16x8 vB[4] = {PK8(vn[0], 0), PK8(vn[0], 8), PK8(vn[1], 0), PK8(vn[1], 8)};
            f32x16 o[2];
#pragma unroll
            for (int a = 0; a < 2; ++a) { o[a] = (f32x16){};
#pragma unroll
                for (int ks = 0; ks < 4; ++ks) o[a] = __builtin_amdgcn_mfma_f32_32x32x16_bf16(FR(8 + a * 4 + ks), sB[ks], o[a], 0, 0, 0);
#pragma unroll
                for (int ks = 0; ks < 4; ++ks) o[a] = __builtin_amdgcn_mfma_f32_32x32x16_bf16(FR(16 + a * 4 + ks), vB[ks], o[a], 0, 0, 0); }
            s0 = s0 * sd; s1 = s1 * sd;
#pragma unroll
            for (int ks = 0; ks < 4; ++ks) { s0 = __builtin_amdgcn_mfma_f32_32x32x16_bf16(FR(24 + ks), vB[ks], s0, 0, 0, 0); s1 = __builtin_amdgcn_mfma_f32_32x32x16_bf16(FR(28 + ks), vB[ks], s1, 0, 0, 0); }
#pragma unroll
            for (int a = 0; a < 2; ++a)
#pragma unroll
                for (int r = 0; r < 16; ++r) { const int i = 32 * a + (r & 3) + 8 * (r >> 2) + 4 * hh; __builtin_nontemporal_store(o[a][r], &obase[(size_t)(dir * NTOK + chunk_row(dir, b, cc, i)) * C_W + ocol]); }
#undef FR
#undef PK8
        }
    }
    asm volatile("s_waitcnt vmcnt(0) lgkmcnt(0)\n\ts_barrier" ::: "memory");
#undef GDN_DMA
}
#undef GDN_FENCE
}

namespace rowp {
typedef float f32x4 __attribute__((ext_vector_type(4)));
typedef unsigned u32x4 __attribute__((ext_vector_type(4)));
typedef unsigned u32x2 __attribute__((ext_vector_type(2)));
typedef float f32x2_t __attribute__((ext_vector_type(2))); typedef __bf16 bf16x2_t __attribute__((ext_vector_type(2)));
#define RLAS __attribute__((address_space(3)))
__device__ __forceinline__ unsigned pk(float lo, float hi) { const f32x2_t v = {lo, hi}; return __builtin_bit_cast(unsigned, __builtin_convertvector(v, bf16x2_t)); }
__device__ __forceinline__ float blo(unsigned u) { return __uint_as_float(u << 16); }
__device__ __forceinline__ float bhi(unsigned u) { return __uint_as_float(u & 0xffff0000u); }
template <int CTRL> __device__ __forceinline__ float dppf(float v) { return __int_as_float(__builtin_amdgcn_update_dpp(0, __float_as_int(v), CTRL, 0xf, 0xf, true)); }
constexpr int DPP_X1 = 0xB1, DPP_X2 = 0x4E, DPP_HMIR = 0x141, DPP_MIR = 0x140;
struct F2 { float a, b; };
__device__ __forceinline__ F2 swap16(float x, float y) { auto rr = __builtin_amdgcn_permlane16_swap(__float_as_uint(x), __float_as_uint(y), false, false); return F2{__uint_as_float(rr[0]), __uint_as_float(rr[1])}; }
__device__ __forceinline__ F2 swap32(float x, float y) { auto rr = __builtin_amdgcn_permlane32_swap(__float_as_uint(x), __float_as_uint(y), false, false); return F2{__uint_as_float(rr[0]), __uint_as_float(rr[1])}; }
__device__ __forceinline__ float sum8(float v) { v += dppf<DPP_X1>(v); v += dppf<DPP_X2>(v); v += dppf<DPP_HMIR>(v); return v; }
__device__ __forceinline__ float wsum(float v, int) { v = sum8(v); v += dppf<DPP_MIR>(v); { const F2 r = swap16(v, v); v = r.a + r.b; } { const F2 r = swap32(v, v); v = r.a + r.b; } return v; }
__device__ __forceinline__ float fsilu(float x) { return x * __builtin_amdgcn_rcpf(1.0f + __expf(-x)); }
struct Lane { int tid, lane, wid; };
__device__ __forceinline__ Lane mk_lane() { int t = ktid(); asm volatile("" : "+v"(t)); Lane L; L.tid = t; L.lane = t & 63; L.wid = __builtin_amdgcn_readfirstlane(t >> 6); return L; }
static_assert(D_MODEL == 1024 && N_EXPERTS == 16 && C_HEADS == 8 && HD == 64, "row-phase geometry");
__device__ __forceinline__ void ln_stats(const f32x4 (&v)[4], float& mean, float& rstd, int lane) {
    float s = 0.f;
#pragma unroll
    for (int j = 0; j < 4; ++j) s += (v[j][0] + v[j][1]) + (v[j][2] + v[j][3]);
    mean = wsum(s, lane) * (1.0f / D_MODEL); float q = 0.f;
#pragma unroll
    for (int j = 0; j < 4; ++j) { const f32x4 d = v[j] - mean; q += (d[0] * d[0] + d[1] * d[1]) + (d[2] * d[2] + d[3] * d[3]); }
    rstd = 1.0f / sqrtf(wsum(q, lane) * (1.0f / D_MODEL) + LN_EPS);
}
__device__ __forceinline__ void store_mod_h(bf16_t* hrow, const f32x4 (&v)[4], float mean, float rstd, const float* sh, const float* sc, int lane) {
#pragma unroll
    for (int j = 0; j < 4; ++j) { const int c = 4 * lane + 256 * j; const f32x4 a = *(const f32x4*)(sc + c), b = *(const f32x4*)(sh + c); const f32x4 y = (v[j] - mean) * rstd * (a + 1.0f) + b;
        u32x2 o; o.x = pk(y[0], y[1]); o.y = pk(y[2], y[3]); *(u32x2*)(hrow + c) = o; }
}
__device__ __forceinline__ const float* xrow(const float* X, const float* const* in, int l, int r) {
    return l == 0 ? (r < NLAT ? in[0] + (size_t)r * D_MODEL : in[2] + (size_t)(r - NLAT) * D_MODEL) : X + (size_t)r * D_MODEL; }
__device__ __forceinline__ const float* modrow(const float* MOD, int l, int r, int which) { return MOD + (((size_t)l * (BATCH + 1) + mod_set(r)) * N_MOD + which) * D_MODEL; }

constexpr int IT_IN = (D_MODEL / 64) * (ZN / 32), IT_BR = (BRANCH_W / 64) * (D_MODEL / 32), IT_OUT = (D_MODEL / 64) * (D_MODEL / 32), IT_GU = (D_MODEL / 64) * (2 * D_EXPERT / 32), IT_DN = (D_EXPERT / 64) * (D_MODEL / 32);
constexpr int IT_LAYER = IT_IN + N_BRANCH * IT_BR + IT_OUT + N_EXPERTS * (IT_GU + IT_DN);
__device__ __forceinline__ void transpose_item(const float* S, int lds_, int scol0, bf16_t* D, int K, int drow0, int k0, RLAS float* scr, int lane) {
    f32x4 tv[8];
#pragma unroll
    for (int i = 0; i < 8; ++i) tv[i] = scol0 >= 0 ? *(const f32x4*)(S + (size_t)(k0 + 8 * i + (lane >> 3)) * lds_ + scol0 + 4 * (lane & 7)) : (f32x4){0.f, 0.f, 0.f, 0.f};
#pragma unroll
    for (int i = 0; i < 8; ++i)
#pragma unroll
        for (int e = 0; e < 4; ++e) scr[(8 * i + (lane >> 3)) * 33 + 4 * (lane & 7) + e] = tv[i][e];
    asm volatile("s_waitcnt lgkmcnt(0)" ::: "memory");
    const int ch = lane & 7;
#pragma unroll
    for (int j = 0; j < 4; ++j) { const int n = (lane >> 3) + 8 * j; const RLAS float* s = scr + (8 * ch) * 33 + n;
        u32x4 o; o.x = pk(s[0 * 33], s[1 * 33]); o.y = pk(s[2 * 33], s[3 * 33]); o.z = pk(s[4 * 33], s[5 * 33]); o.w = pk(s[6 * 33], s[7 * 33]);
        *(u32x4*)(D + (size_t)(drow0 + n) * K + k0 + 8 * ch) = o; }
    asm volatile("s_waitcnt lgkmcnt(0)" ::: "memory");
}
__device__ __forceinline__ void convert_item(unsigned char* wsb, const float* const* in, int l, int r, RLAS float* scr, int lane) {
        if (r < IT_IN) { const int nb = r % (ZN / 32), kb = r / (ZN / 32); const int o = zcol2orig(nb * 32);
            transpose_item(in[6] + (size_t)l * D_MODEL * D_IN, D_IN, o, (bf16_t*)ws_at(wsb, WSO.WinT) + (size_t)l * ZN * D_MODEL, D_MODEL, nb * 32, kb * 64, scr, lane); return; }
        r -= IT_IN;
        if (r < N_BRANCH * IT_BR) { const int br = r / IT_BR, q = r % IT_BR, nb = q % (D_MODEL / 32), kb = q / (D_MODEL / 32);
            transpose_item(in[13] + ((size_t)l * N_BRANCH + br) * BRANCH_W * D_MODEL, D_MODEL, nb * 32, (bf16_t*)ws_at(wsb, WSO.WbrT) + ((size_t)l * N_BRANCH + br) * D_MODEL * BRANCH_W, BRANCH_W, nb * 32, kb * 64, scr, lane); return; }
        r -= N_BRANCH * IT_BR;
        if (r < IT_OUT) { const int nb = r % (D_MODEL / 32), kb = r / (D_MODEL / 32);
            transpose_item(in[14] + (size_t)l * D_MODEL * D_MODEL, D_MODEL, nb * 32, (bf16_t*)ws_at(wsb, WSO.WoutT) + (size_t)l * D_MODEL * D_MODEL, D_MODEL, nb * 32, kb * 64, scr, lane); return; }
        r -= IT_OUT;
        if (r < N_EXPERTS * IT_GU) { const int e = r / IT_GU, q = r % IT_GU, nb = q % (2 * D_EXPERT / 32), kb = q / (2 * D_EXPERT / 32); const int row = nb * 32;
            const int blk = row / (2 * GU_BLK), rem = row % (2 * GU_BLK), half = rem / GU_BLK, col = half * D_EXPERT + blk * GU_BLK + rem % GU_BLK;
            transpose_item(in[18] + ((size_t)l * N_EXPERTS + e) * D_MODEL * 2 * D_EXPERT, 2 * D_EXPERT, col, (bf16_t*)ws_at(wsb, WSO.WguT) + ((size_t)l * N_EXPERTS + e) * 2 * D_EXPERT * D_MODEL, D_MODEL, row, kb * 64, scr, lane); return; }
        r -= N_EXPERTS * IT_GU;
        { const int e = r / IT_DN, q = r % IT_DN, nb = q % (D_MODEL / 32), kb = q / (D_MODEL / 32);
            transpose_item(in[19] + ((size_t)l * N_EXPERTS + e) * D_EXPERT * D_MODEL, D_MODEL, nb * 32, (bf16_t*)ws_at(wsb, WSO.WdnT) + ((size_t)l * N_EXPERTS + e) * D_MODEL * D_EXPERT, D_EXPERT, nb * 32, kb * 64, scr, lane); }
}
constexpr int CONV_UNIT = 16;
__device__ __forceinline__ void convert_queue(unsigned char* wsb, const float* const* in, unsigned* ctr, int l, int max_units, char* lds) {
    const Lane T = mk_lane(); const int lane = T.lane, wid = T.wid;
    RLAS float* scr = (RLAS float*)((RLAS char*)lds + wid * 16384);
    volatile RLAS unsigned* w = (volatile RLAS unsigned*)((RLAS char*)lds + 131072 + 128);
    for (int n = 0; max_units < 0 || n < max_units; ++n) {
        if (T.tid == 0) w[0] = __hip_atomic_fetch_add(ctr, 1u, __ATOMIC_RELAXED, __HIP_MEMORY_SCOPE_AGENT);
        __syncthreads(); const int u = (int)w[0]; __syncthreads();
        if (u * CONV_UNIT >= IT_LAYER) break;
        const int e_ = (u + 1) * CONV_UNIT < IT_LAYER ? (u + 1) * CONV_UNIT : IT_LAYER;
        for (int it = u * CONV_UNIT + wid; it < e_; it += 8) convert_item(wsb, in, l, it, scr, lane);
    }
    __syncthreads();
}
__device__ __forceinline__ void prologue_a(unsigned char* wsb, const float* const* in, char* lds, int G, int c) {
    const Lane T = mk_lane(); const int lane = T.lane, wid = T.wid;
    RLAS float* scr = (RLAS float*)((RLAS char*)lds + wid * 16384);
    const int gw = c * 8 + wid, NGW = G * 8;
#pragma unroll 1
    for (int step = 0; step < 2; ++step) { if (((c & 1) == 0) == (step == 0)) {
    for (int it = gw; it < IT_LAYER; it += NGW) convert_item(wsb, in, 0, it, scr, lane);
    { float* ROPE = (float*)ws_at(wsb, WSO.ROPE);
      for (int i = c * 512 + T.tid; i < ROPE_P * NFREQ; i += G * 512) { const int f = i % NFREQ, p = i / NFREQ; const float inv = exp2f(-(float)f / NFREQ * 13.287712379549449f);
        float s, cs; sincos_rr((float)p * inv, s, cs); ROPE[2 * i] = cs; ROPE[2 * i + 1] = s; } }
    } else
    { RLAS float* sil = (RLAS float*)lds;
      RLAS float* red = (RLAS float*)((RLAS char*)lds + 40960);
      for (int i = T.tid; i < (BATCH + 1) * D_MODEL; i += 512) { const int s = i / D_MODEL, k = i % D_MODEL; const float v = s < BATCH ? in[1][s * D_MODEL + k] : in[3][k]; sil[i] = fsilu(v); }
      __syncthreads();
      float* MOD = (float*)ws_at(wsb, WSO.MOD);
      for (int task = c; task < DEPTH * (N_MOD * D_MODEL / 64); task += G) { const int l = task / (N_MOD * D_MODEL / 64), j = (task % (N_MOD * D_MODEL / 64)) * 64 + lane;
        const float* wm = in[4] + (size_t)l * D_MODEL * N_MOD * D_MODEL + j; float acc[BATCH + 1];
#pragma unroll
        for (int s = 0; s <= BATCH; ++s) acc[s] = 0.f;
        for (int k0 = wid * 128; k0 < wid * 128 + 128; k0 += 16) { float wv[16];
#pragma unroll
            for (int q = 0; q < 16; ++q) wv[q] = wm[(size_t)(k0 + q) * N_MOD * D_MODEL];
#pragma unroll
            for (int q = 0; q < 16; ++q)
#pragma unroll
                for (int s = 0; s <= BATCH; ++s) acc[s] += sil[s * D_MODEL + k0 + q] * wv[q]; }
#pragma unroll
        for (int s = 0; s <= BATCH; ++s) red[(wid * (BATCH + 1) + s) * 64 + lane] = acc[s];
        __syncthreads();
        for (int i = T.tid; i < (BATCH + 1) * 64; i += 512) { const int s = i / 64, jj = i % 64; float t = in[5][(size_t)l * N_MOD * D_MODEL + (task % (N_MOD * D_MODEL / 64)) * 64 + jj];
#pragma unroll
            for (int w = 0; w < 8; ++w) t += red[(w * (BATCH + 1) + s) * 64 + jj];
            MOD[((size_t)l * (BATCH + 1) + s) * N_MOD * D_MODEL + (task % (N_MOD * D_MODEL / 64)) * 64 + jj] = t; }
        __syncthreads(); }
    }
    __syncthreads(); }
}
__device__ __forceinline__ void prologue_b(unsigned char* wsb, const float* const* in, char* lds, int G, int c) {
    const Lane T = mk_lane(); const int lane = T.lane;
    float* X = (float*)ws_at(wsb, WSO.X); bf16_t* H = (bf16_t*)ws_at(wsb, WSO.H); const float* MOD = (const float*)ws_at(wsb, WSO.MOD);
    RLAS float* cmod = (RLAS float*)lds;
    const int per = (NTOK + G - 1) / G, rbeg = c * per, rend = rbeg + per < NTOK ? rbeg + per : NTOK;
    const int set0 = mod_set(rbeg < NTOK ? rbeg : 0), set1 = mod_set(rend > rbeg ? rend - 1 : 0);
    { float t_[8];
#pragma unroll
      for (int u = 0; u < 8; ++u) { const int i = T.tid + 512 * u, s = i / (2 * D_MODEL), wh = (i / D_MODEL) % 2, k = i % D_MODEL; t_[u] = MOD[(((size_t)(s ? set1 : set0)) * N_MOD + wh) * D_MODEL + k]; }
#pragma unroll
      for (int u = 0; u < 8; ++u) cmod[T.tid + 512 * u] = t_[u]; }
    __syncthreads();
#define PB_SRC(rr) ((rr) < NLAT ? in[0] + (size_t)(rr) * D_MODEL : in[2] + (size_t)((rr) - NLAT) * D_MODEL)
    f32x4 nv[4];
    { const int r0 = rbeg + T.wid; if (r0 < rend) { const float* src = PB_SRC(r0);
#pragma unroll
        for (int j = 0; j < 4; ++j) nv[j] = *(const f32x4*)(src + 4 * lane + 256 * j); } }
    for (int r = rbeg + T.wid; r < rend; r += 8) { f32x4 v[4];
#pragma unroll
        for (int j = 0; j < 4; ++j) v[j] = nv[j];
        if (r + 8 < rend) { const float* src = PB_SRC(r + 8);
#pragma unroll
            for (int j = 0; j < 4; ++j) nv[j] = *(const f32x4*)(src + 4 * lane + 256 * j); }
        (void)X;
        float mean, rstd; ln_stats(v, mean, rstd, lane);
        const RLAS float* cm = cmod + (mod_set(r) == set0 ? 0 : 2 * D_MODEL);
#pragma unroll
        for (int j = 0; j < 4; ++j) { const int cc = 4 * lane + 256 * j; const f32x4 y = (v[j] - mean) * rstd * (*(const RLAS f32x4*)(cm + D_MODEL + cc) + 1.0f) + *(const RLAS f32x4*)(cm + cc);
            u32x2 o; o.x = pk(y[0], y[1]); o.y = pk(y[2], y[3]); *(u32x2*)(H + (size_t)r * D_MODEL + cc) = o; } }
#undef PB_SRC
}
__device__ __forceinline__ void prep_phase(unsigned char* wsb, const float* const* in, int l, char* lds, int G, int c) {
    const Lane T = mk_lane(); const int lane = T.lane, sub = lane & 7;
    const bf16_t* Z = (const bf16_t*)ws_at(wsb, WSO.Z); const float* ROPE = (const float*)ws_at(wsb, WSO.ROPE);
    bf16_t* QA = (bf16_t*)ws_at(wsb, WSO.QA); bf16_t* KA = (bf16_t*)ws_at(wsb, WSO.KA); bf16_t* VA = (bf16_t*)ws_at(wsb, WSO.VA);
    bf16_t* QC = (bf16_t*)ws_at(wsb, WSO.QC); bf16_t* KC = (bf16_t*)ws_at(wsb, WSO.KC); bf16_t* VC = (bf16_t*)ws_at(wsb, WSO.VC);
    float* Gd = (float*)ws_at(wsb, WSO.G); float* Bd = (float*)ws_at(wsb, WSO.BETA);
    const float* qk_gain = in[7] + (size_t)l * 2 * HD; const float* conv_w = in[9] + (size_t)l * CONV_K * 3 * C_W;
    float cw[3][CONV_K][8], gq[8], gk[8];
#pragma unroll
    for (int p = 0; p < 3; ++p)
#pragma unroll
        for (int j = 0; j < CONV_K; ++j) { const float* wv = conv_w + (size_t)j * 3 * C_W + p * C_W + 8 * lane; const f32x4 w0 = *(const f32x4*)wv, w1 = *(const f32x4*)(wv + 4);
#pragma unroll
            for (int e = 0; e < 4; ++e) { cw[p][j][e] = w0[e]; cw[p][j][4 + e] = w1[e]; } }
#pragma unroll
    for (int e = 0; e < 8; ++e) { gq[e] = qk_gain[8 * sub + e]; gk[e] = qk_gain[HD + 8 * sub + e]; }
    const float mya = lane < 2 * C_HEADS ? -__expf(in[10][(size_t)l * 2 * C_HEADS + lane]) : 0.f, mydt = lane < 2 * C_HEADS ? in[11][(size_t)l * 2 * C_HEADS + lane] : 0.f;
    const int gw = c * 8 + T.wid, per = (NTOK + G * 8 - 1) / (G * 8), rbeg = gw * per, rend = rbeg + per < NTOK ? rbeg + per : NTOK;
    const u32x4 zero4 = {0u, 0u, 0u, 0u};
    u32x4 win[3][5];
#define PREP_LDROW(rr, p) (*(const u32x4*)(Z + (size_t)((rr) < 0 ? 0 : (rr) >= NTOK ? NTOK - 1 : (rr)) * ZN + ZC_QKVC + (p) * C_W + 8 * lane))
    RLAS float* ropel = (RLAS float*)lds;
    { float t_[ROPE_P * NFREQ * 2 / 512];
#pragma unroll
      for (int u = 0; u < ROPE_P * NFREQ * 2 / 512; ++u) t_[u] = ROPE[T.tid + 512 * u];
#pragma unroll
      for (int u = 0; u < ROPE_P * NFREQ * 2 / 512; ++u) ropel[T.tid + 512 * u] = t_[u]; }
    static_assert(ROPE_P * NFREQ * 2 % 512 == 0, "rope table fill");
    __syncthreads();
    u32x4 nq = zero4, nkv = zero4; bf16_t na = 0, nb = 0;
#define PREP_LDNEXT(rr) do { const bf16_t* zn_ = Z + (size_t)(rr) * ZN; nq = *(const u32x4*)(zn_ + ZC_QA + 8 * lane); if (lane < 32) nkv = *(const u32x4*)(zn_ + (lane < 16 ? ZC_KA + 8 * lane : ZC_VA + 8 * (lane - 16))); \
        if (lane < 2 * C_HEADS) { na = zn_[ZC_A + lane]; nb = zn_[ZC_B + lane]; } } while (0)
    if (rbeg < rend) {
#pragma unroll
        for (int p = 0; p < 3; ++p)
#pragma unroll
            for (int j = 0; j < 4; ++j) win[p][j + 1] = PREP_LDROW(rbeg + j - 2, p);
        PREP_LDNEXT(rbeg); }
    for (int r = rbeg; r < rend; ++r) {
        const u32x4 rawq = nq, rawkv = nkv; const bf16_t ra = na, rb = nb;
#pragma unroll
        for (int p = 0; p < 3; ++p) {
#pragma unroll
            for (int j = 0; j < 4; ++j) win[p][j] = win[p][j + 1];
            win[p][4] = PREP_LDROW(r + 2, p); }
        if (r + 1 < rend) PREP_LDNEXT(r + 1);
        const bool lat = r < NLAT; const int b = lat ? r / SEQ : (r - NLAT) / CTX_LEN, t = lat ? r % SEQ : (r - NLAT) % CTX_LEN, len = lat ? SEQ : CTX_LEN;
        const size_t kvrow = (size_t)b * KVLEN + (lat ? t : SEQ + t); const bf16_t* zr = Z + (size_t)r * ZN;
#pragma unroll
        for (int pass = 0; pass < 2; ++pass) {
            if (pass == 1 && lane >= 16) { if (lane < 32) *(u32x4*)(VA + kvrow * A_KV_W + 8 * (lane - 16)) = rawkv; continue; }
            const u32x4 raw = pass == 0 ? rawq : rawkv; float v[8];
#pragma unroll
            for (int e = 0; e < 4; ++e) { v[2 * e] = blo(raw[e]); v[2 * e + 1] = bhi(raw[e]); }
            float ss = 0.f;
#pragma unroll
            for (int e = 0; e < 8; ++e) ss += v[e] * v[e];
            ss = sum8(ss);
            const float rs = 1.0f / sqrtf(ss * (1.0f / HD) + LN_EPS);
#pragma unroll
            for (int e = 0; e < 8; ++e) v[e] = v[e] * rs * (pass == 0 ? gq[e] : gk[e]);
            if (lat) { const int quarter = sub >> 1, f0 = (8 * sub) & 15;
                const RLAS float* tab = ropel + (quarter < 2 ? t / GRID_W : t % GRID_W) * NFREQ * 2 + 2 * f0;
#pragma unroll
                for (int e = 0; e < 8; ++e) { const float other = dppf<DPP_X2>(v[e]), cs = tab[2 * e], sn = tab[2 * e + 1]; v[e] = (quarter & 1) ? v[e] * cs + other * sn : v[e] * cs - other * sn; } }
            u32x4 o;
            if (pass == 0) { o.x = pk(v[0] * QSCALE, v[1] * QSCALE); o.y = pk(v[2] * QSCALE, v[3] * QSCALE); o.z = pk(v[4] * QSCALE, v[5] * QSCALE); o.w = pk(v[6] * QSCALE, v[7] * QSCALE); *(u32x4*)(QA + (size_t)r * A_Q_W + 8 * lane) = o; }
            else { o.x = pk(v[0], v[1]); o.y = pk(v[2], v[3]); o.z = pk(v[4], v[5]); o.w = pk(v[6], v[7]); *(u32x4*)(KA + kvrow * A_KV_W + 8 * lane) = o; }
        }
#pragma unroll
        for (int part = 0; part < 3; ++part) { float y[8];
#pragma unroll
            for (int e = 0; e < 8; ++e) y[e] = 0.f;
#pragma unroll
            for (int j = 0; j < CONV_K; ++j) { const int tt = t + j - CONV_K / 2; const float m = (tt >= 0 && tt < len) ? 1.0f : 0.0f; const u32x4 raw = win[part][j];
#pragma unroll
                for (int e = 0; e < 4; ++e) { y[2 * e] += blo(raw[e]) * (cw[part][j][2 * e] * m); y[2 * e + 1] += bhi(raw[e]) * (cw[part][j][2 * e + 1] * m); } }
            float ss = 0.f;
#pragma unroll
            for (int e = 0; e < 8; ++e) { y[e] = fsilu(y[e]); ss += y[e] * y[e]; }
            ss = sum8(ss);
            const float sc = part == 0 ? 0.125f / sqrtf(ss + LN_EPS) : part == 1 ? 1.0f / sqrtf(ss + LN_EPS) : 1.0f;
            u32x4 o; o.x = pk(y[0] * sc, y[1] * sc); o.y = pk(y[2] * sc, y[3] * sc); o.z = pk(y[4] * sc, y[5] * sc); o.w = pk(y[6] * sc, y[7] * sc);
            *(u32x4*)((part == 0 ? QC : part == 1 ? KC : VC) + (size_t)r * C_W + 8 * lane) = o; }
        if (lane < 2 * C_HEADS) { const float a = bf2f(ra), bt = bf2f(rb); const float x = a + mydt;
            Gd[(size_t)r * 2 * C_HEADS + lane] = mya * (x > 20.f ? x : ({ const float ex_ = __expf(x); ex_ < 0.03125f ? ex_ * (1.0f - ex_ * (0.5f - ex_ * 0.33333334f)) : __logf(1.0f + ex_); })); Bd[(size_t)r * 2 * C_HEADS + lane] = 1.0f / (1.0f + __expf(-bt)); }
    }
#undef PREP_LDROW
#undef PREP_LDNEXT
}
__device__ __forceinline__ void gdn_fin_rows(unsigned char* wsb, const float* const* in, int l, int rfirst, int rstep, int nrows) {
    const Lane T = mk_lane(); const int lane = T.lane, sub = lane & 7;
    const float* OCD = (const float*)ws_at(wsb, WSO.OCD); const bf16_t* Z = (const bf16_t*)ws_at(wsb, WSO.Z); bf16_t* OC = (bf16_t*)ws_at(wsb, WSO.OC); const float* og = in[12] + (size_t)l * HD + 8 * sub;
    f32x4 na0, na1, nb0, nb1; u32x4 ngt;
    { const int r0 = rfirst + T.wid; if (r0 < nrows) { const float* p0 = OCD + (size_t)r0 * C_W + 8 * lane; const float* p1 = p0 + (size_t)NTOK * C_W;
        na0 = *(const f32x4*)p0; na1 = *(const f32x4*)(p0 + 4); nb0 = *(const f32x4*)p1; nb1 = *(const f32x4*)(p1 + 4); ngt = *(const u32x4*)(Z + (size_t)r0 * ZN + ZC_GC + 8 * lane); } }
    for (int r = rfirst + T.wid; r < nrows; r += rstep) { float o[8];
        const f32x4 a0 = na0, a1 = na1, b0 = nb0, b1 = nb1; const u32x4 gt = ngt;
        if (r + rstep < nrows) { const float* p0 = OCD + (size_t)(r + rstep) * C_W + 8 * lane; const float* p1 = p0 + (size_t)NTOK * C_W;
            na0 = *(const f32x4*)p0; na1 = *(const f32x4*)(p0 + 4); nb0 = *(const f32x4*)p1; nb1 = *(const f32x4*)(p1 + 4); ngt = *(const u32x4*)(Z + (size_t)(r + rstep) * ZN + ZC_GC + 8 * lane); }
#pragma unroll
        for (int e = 0; e < 4; ++e) { o[e] = a0[e] + b0[e]; o[4 + e] = a1[e] + b1[e]; }
        float ss = 0.f;
#pragma unroll
        for (int e = 0; e < 8; ++e) ss += o[e] * o[e];
        ss = sum8(ss);
        const float rs = 1.0f / sqrtf(ss * (1.0f / HD) + LN_EPS);
        u32x4 out;
#pragma unroll
        for (int e = 0; e < 4; ++e) out[e] = pk(o[2 * e] * rs * og[2 * e] * fsilu(blo(gt[e])), o[2 * e + 1] * rs * og[2 * e + 1] * fsilu(bhi(gt[e])));
        *(u32x4*)(OC + (size_t)r * BRANCH_W + 8 * lane) = out; }
}
__device__ __forceinline__ void ln1_phase(unsigned char* wsb, const float* const* in, int l, float alpha, int nrows, char* lds, int G, int c) {
    const Lane T = mk_lane(); const int lane = T.lane;
    float* X = (float*)ws_at(wsb, WSO.X); bf16_t* H = (bf16_t*)ws_at(wsb, WSO.H); const float* MOD = (const float*)ws_at(wsb, WSO.MOD); float* AFFT = (float*)ws_at(wsb, WSO.AFF); const bf16_t* MIX = (const bf16_t*)ws_at(wsb, WSO.OA);
    const float* g1 = in[15] + (size_t)l * D_MODEL; const float* b1 = in[16] + (size_t)l * D_MODEL; const float* wr = in[17] + (size_t)l * D_MODEL * N_EXPERTS;
    RLAS float* wrt = (RLAS float*)lds;
    RLAS float* cg1 = wrt + N_EXPERTS * D_MODEL; RLAS float* cb1 = cg1 + D_MODEL; RLAS float* cmod = cb1 + D_MODEL;
    const int per = (nrows + G - 1) / G, rbeg = c * per, rend = rbeg + per < nrows ? rbeg + per : nrows;
    const int set0 = mod_set(rbeg < nrows ? rbeg : 0), set1 = mod_set(rend > rbeg ? rend - 1 : 0);
    for (int k = T.tid; k < D_MODEL; k += 512) { f32x4 t_[4];
#pragma unroll
        for (int u = 0; u < 4; ++u) t_[u] = *(const f32x4*)(wr + (size_t)k * N_EXPERTS + 4 * u);
#pragma unroll
        for (int u = 0; u < 4; ++u)
#pragma unroll
            for (int e = 0; e < 4; ++e) wrt[(4 * u + e) * D_MODEL + k] = t_[u][e]; }
    { float t_[16];
#pragma unroll
      for (int u = 0; u < 2; ++u) { t_[u] = g1[T.tid + 512 * u]; t_[2 + u] = b1[T.tid + 512 * u]; }
#pragma unroll
      for (int u = 0; u < 12; ++u) { const int i = T.tid + 512 * u, s = i / (3 * D_MODEL), wh = (i / D_MODEL) % 3, k = i % D_MODEL; t_[4 + u] = MOD[(((size_t)l * (BATCH + 1) + (s ? set1 : set0)) * N_MOD + 2 + wh) * D_MODEL + k]; }
#pragma unroll
      for (int u = 0; u < 2; ++u) { cg1[T.tid + 512 * u] = t_[u]; cb1[T.tid + 512 * u] = t_[2 + u]; }
#pragma unroll
      for (int u = 0; u < 12; ++u) cmod[T.tid + 512 * u] = t_[4 + u]; }
    static_assert(D_MODEL == 1024 && N_EXPERTS == 16, "LN1 fill shapes");
    __syncthreads();
    f32x4 wc0[N_EXPERTS];
#pragma unroll
    for (int e = 0; e < N_EXPERTS; ++e) wc0[e] = *(const RLAS f32x4*)(wrt + e * D_MODEL + 4 * lane);
    f32x4 nv[4]; u32x2 nm[4];
    { const int r0 = rbeg + T.wid; if (r0 < rend) {
#pragma unroll
        for (int j = 0; j < 4; ++j) { nv[j] = *(const f32x4*)(xrow(X, in, l, r0) + 4 * lane + 256 * j); nm[j] = *(const u32x2*)(MIX + (size_t)r0 * D_MODEL + 4 * lane + 256 * j); } } }
    for (int r = rbeg + T.wid; r < rend; r += 8) { f32x4 v[4]; u32x2 mxv[4];
#pragma unroll
        for (int j = 0; j < 4; ++j) { v[j] = nv[j]; mxv[j] = nm[j]; }
        if (r + 8 < rend) {
#pragma unroll
            for (int j = 0; j < 4; ++j) { nv[j] = *(const f32x4*)(xrow(X, in, l, r + 8) + 4 * lane + 256 * j); nm[j] = *(const u32x2*)(MIX + (size_t)(r + 8) * D_MODEL + 4 * lane + 256 * j); } }
        const RLAS float* cm = cmod + (mod_set(r) == set0 ? 0 : 3 * D_MODEL);
#pragma unroll
        for (int j = 0; j < 4; ++j) { const int cc = 4 * lane + 256 * j; const u32x2 w2 = mxv[j]; const f32x4 g = *(const RLAS f32x4*)(cm + cc);
            v[j][0] = alpha * v[j][0] + g[0] * blo(w2.x); v[j][1] = alpha * v[j][1] + g[1] * bhi(w2.x); v[j][2] = alpha * v[j][2] + g[2] * blo(w2.y); v[j][3] = alpha * v[j][3] + g[3] * bhi(w2.y); }
        float mean, rstd; ln_stats(v, mean, rstd, lane);
#pragma unroll
        for (int j = 0; j < 4; ++j) { const int cc = 4 * lane + 256 * j; v[j] = (v[j] - mean) * rstd * *(const RLAS f32x4*)(cg1 + cc) + *(const RLAS f32x4*)(cb1 + cc); }
        ln_stats(v, mean, rstd, lane);
        float lg[N_EXPERTS];
#pragma unroll
        for (int e = 0; e < N_EXPERTS; ++e) lg[e] = 0.f;
#pragma unroll
        for (int j = 0; j < 4; ++j) { const int cc = 4 * lane + 256 * j; const f32x4 y = (v[j] - mean) * rstd * (*(const RLAS f32x4*)(cm + 2 * D_MODEL + cc) + 1.0f) + *(const RLAS f32x4*)(cm + D_MODEL + cc);
            u32x2 o; o.x = pk(y[0], y[1]); o.y = pk(y[2], y[3]); *(u32x2*)(H + (size_t)r * D_MODEL + cc) = o;
            f32x4 w4[N_EXPERTS];
#pragma unroll
            for (int e = 0; e < N_EXPERTS; ++e) w4[e] = j == 0 ? wc0[e] : *(const RLAS f32x4*)(wrt + e * D_MODEL + cc);
            asm volatile("" ::: "memory");
#pragma unroll
            for (int e = 0; e < N_EXPERTS; ++e) lg[e] += (y[0] * w4[e][0] + y[1] * w4[e][1]) + (y[2] * w4[e][2] + y[3] * w4[e][3]);
            asm volatile("" ::: "memory"); }
        float a1;
        { float a8[8], a4[4], a2[2];
#pragma unroll
          for (int i = 0; i < 8; ++i) { const F2 r = swap32(lg[i], lg[8 + i]); a8[i] = r.a + r.b; }
#pragma unroll
          for (int i = 0; i < 4; ++i) { const F2 r = swap16(a8[i], a8[4 + i]); a4[i] = r.a + r.b; }
#pragma unroll
          for (int i = 0; i < 2; ++i) { const float snd = (lane & 8) ? a4[i] : a4[2 + i], kp = (lane & 8) ? a4[2 + i] : a4[i]; a2[i] = kp + dppf<DPP_MIR>(snd); }
          { const float snd = (lane & 4) ? a2[0] : a2[1], kp = (lane & 4) ? a2[1] : a2[0]; a1 = kp + dppf<DPP_HMIR>(snd); }
          a1 += dppf<DPP_X2>(a1); a1 += dppf<DPP_X1>(a1); }
        static_assert(N_EXPERTS == 16, "halving exchange is written for sixteen experts");
        float mx = a1;
        mx = fmaxf(mx, dppf<DPP_HMIR>(mx)); mx = fmaxf(mx, dppf<DPP_MIR>(mx)); { const F2 r = swap16(mx, mx); mx = fmaxf(r.a, r.b); } { const F2 r = swap32(mx, mx); mx = fmaxf(r.a, r.b); }
        const float pe = __expf(a1 - mx); float sm = pe;
        sm += dppf<DPP_HMIR>(sm); sm += dppf<DPP_MIR>(sm); { const F2 r = swap16(sm, sm); sm = r.a + r.b; } { const F2 r = swap32(sm, sm); sm = r.a + r.b; }
        if ((lane & 3) == 0) AFFT[(size_t)(lane >> 2) * NTOK + r] = pe / sm; }
    __syncthreads();
}
__device__ __forceinline__ void topk_phase(unsigned char* wsb, int ngroups, char* lds, int G, int c) {
    const Lane T = mk_lane(); const int tid = T.tid, lane = T.lane, wid = T.wid;
    const float* AFFT = (const float*)ws_at(wsb, WSO.AFF); int* TOKLIST = (int*)ws_at(wsb, WSO.TOKLIST); float* GATEV = (float*)ws_at(wsb, WSO.GATEV); int* SLOTOF = (int*)ws_at(wsb, WSO.SLOTOF);
    const bf16_t* H = (const bf16_t*)ws_at(wsb, WSO.H); bf16_t* XS = (bf16_t*)ws_at(wsb, WSO.XS);
    RLAS unsigned* hist = (RLAS unsigned*)lds;
    RLAS unsigned* sh = hist + 256;
    RLAS int* toks = (RLAS int*)(hist + 512);
    for (int g = c; g < ngroups; g += G) {
        const bool lat = g < BATCH * N_EXPERTS; const int gg = lat ? g : g - BATCH * N_EXPERTS, b = gg / N_EXPERTS, e = gg % N_EXPERTS;
        const int len = lat ? SEQ : CTX_LEN, cap = lat ? CAP_L : CAP_C, base = lat ? b * SEQ : NLAT + b * CTX_LEN, slot0 = lat ? (e * BATCH + b) * CAP_L : NSLOT_L + (e * BATCH + b) * CAP_C;
        constexpr int VPT = SEQ / 512; const int nv = lat ? VPT : (tid < CTX_LEN ? 1 : 0), i0 = lat ? tid * VPT : tid;
        unsigned key[VPT];
#pragma unroll
        for (int j = 0; j < VPT; ++j) key[j] = j < nv ? __float_as_uint(AFFT[(size_t)e * NTOK + base + i0 + j]) : 0u;
        unsigned prefix = 0u, want = (unsigned)cap;
#pragma unroll
        for (int pass = 0; pass < 4; ++pass) { const int shft = 24 - 8 * pass; const unsigned himask = pass == 0 ? 0u : (0xffffffffu << (shft + 8));
            if (tid < 256) hist[tid] = 0u;
            __syncthreads();
#pragma unroll
            for (int j = 0; j < VPT; ++j) if (j < nv && (key[j] & himask) == prefix) __hip_atomic_fetch_add(&hist[(key[j] >> shft) & 255u], 1u, __ATOMIC_RELAXED, __HIP_MEMORY_SCOPE_WORKGROUP);
            __syncthreads();
            if (wid == 0) {
                unsigned cnt[4]; unsigned tot = 0u;
#pragma unroll
                for (int q = 0; q < 4; ++q) { cnt[q] = hist[255 - (4 * lane + q)]; tot += cnt[q]; }
                unsigned incl = tot;
#pragma unroll
                for (int o = 1; o < 64; o <<= 1) { const unsigned t = shu_idx(incl, lane - o); if (lane >= o) incl += t; }
                unsigned before = incl - tot;
#pragma unroll
                for (int q = 0; q < 4; ++q) { if (before < want && want <= before + cnt[q]) { sh[0] = prefix | ((unsigned)(255 - (4 * lane + q)) << shft); sh[1] = want - before; } before += cnt[q]; }
            }
            __syncthreads();
            prefix = sh[0]; want = sh[1];
            __syncthreads(); }
        const unsigned thr = prefix; const unsigned need_eq = want;
        unsigned ngt = 0u, neq = 0u;
#pragma unroll
        for (int j = 0; j < VPT; ++j) if (j < nv) { ngt += key[j] > thr ? 1u : 0u; neq += key[j] == thr ? 1u : 0u; }
        unsigned igt = ngt, ieq = neq;
#pragma unroll
        for (int o = 1; o < 64; o <<= 1) { const unsigned t0 = shu_idx(igt, lane - o), t1 = shu_idx(ieq, lane - o); if (lane >= o) { igt += t0; ieq += t1; } }
        if (lane == 63) { sh[8 + wid] = igt; sh[16 + wid] = ieq; }
        __syncthreads();
        unsigned ogt = igt - ngt, oeq = ieq - neq;
#pragma unroll
        for (int w = 0; w < 8; ++w) if (w < wid) { ogt += sh[8 + w]; oeq += sh[16 + w]; }
#pragma unroll
        for (int j = 0; j < VPT; ++j) if (j < nv) { const bool gt = key[j] > thr, eq = key[j] == thr; const bool sel = gt || (eq && oeq < need_eq);
            const unsigned eq_before = oeq < need_eq ? oeq : need_eq; const int pos = (int)(ogt + eq_before); const int r = base + i0 + j;
            if (sel) { TOKLIST[slot0 + pos] = r; GATEV[slot0 + pos] = __uint_as_float(key[j]); }
            SLOTOF[(size_t)r * N_EXPERTS + e] = sel ? slot0 + pos : -1;
            ogt += gt ? 1u : 0u; oeq += eq ? 1u : 0u; }
        __syncthreads();
        __syncthreads();
    }
}
__device__ __forceinline__ void ln2_phase(unsigned char* wsb, const float* const* in, float* out, int l, float alpha, char* lds, int G, int c) {
    const Lane T = mk_lane(); const int lane = T.lane;
    const bf16_t* MIX = (const bf16_t*)ws_at(wsb, WSO.OA); const float* g1 = in[15] + (size_t)l * D_MODEL; const float* b1 = in[16] + (size_t)l * D_MODEL;
    float* X = (float*)ws_at(wsb, WSO.X); bf16_t* H = (bf16_t*)ws_at(wsb, WSO.H); const float* MOD = (const float*)ws_at(wsb, WSO.MOD); const int* SLOTOF = (const int*)ws_at(wsb, WSO.SLOTOF); const bf16_t* YS = (const bf16_t*)ws_at(wsb, WSO.YS);
    const float* g2 = in[20] + (size_t)l * D_MODEL; const float* b2 = in[21] + (size_t)l * D_MODEL;
    const int nrows = l == DEPTH - 1 ? NLAT : NTOK;
    RLAS float* cg = (RLAS float*)lds;
    RLAS float* cmod = cg + 4 * D_MODEL;
    const int per = (nrows + G - 1) / G, rbeg = c * per, rend = rbeg + per < nrows ? rbeg + per : nrows;
    const int set0 = mod_set(rbeg < nrows ? rbeg : 0), set1 = mod_set(rend > rbeg ? rend - 1 : 0);
    { float t_[24];
#pragma unroll
      for (int u = 0; u < 8; ++u) { const int i = T.tid + 512 * u, wh = i / D_MODEL, k = i % D_MODEL; t_[u] = (wh == 0 ? g1 : wh == 1 ? b1 : wh == 2 ? g2 : b2)[k]; }
#pragma unroll
      for (int u = 0; u < 16; ++u) { const int i = T.tid + 512 * u, s = i / (4 * D_MODEL), wh = (i / D_MODEL) % 4, k = i % D_MODEL; const int ll = wh < 2 ? l : l + 1, which = wh == 0 ? 2 : wh == 1 ? 5 : wh - 2;
          t_[8 + u] = ll < DEPTH ? MOD[(((size_t)ll * (BATCH + 1) + (s ? set1 : set0)) * N_MOD + which) * D_MODEL + k] : 0.f; }
#pragma unroll
      for (int u = 0; u < 8; ++u) cg[T.tid + 512 * u] = t_[u];
#pragma unroll
      for (int u = 0; u < 16; ++u) cmod[T.tid + 512 * u] = t_[8 + u]; }
    __syncthreads();
    f32x4 nv[4]; u32x2 nm[4], ny[2][4]; int nslot = -1, nslot2 = -1;
#define LN2_LDY(sl) do { unsigned long long m_ = __builtin_amdgcn_ballot_w64((sl) >= 0); _Pragma("unroll") for (int q_ = 0; q_ < 2; ++q_) { if (m_) { const int e_ = __builtin_ctzll(m_); m_ &= m_ - 1; \
            const bf16_t* ys_ = YS + (size_t)shi_idx((sl), e_) * D_MODEL; _Pragma("unroll") for (int j = 0; j < 4; ++j) ny[q_][j] = *(const u32x2*)(ys_ + 4 * lane + 256 * j); } } } while (0)
    { const int r0 = rbeg + T.wid; if (r0 < rend) { nslot = lane < N_EXPERTS ? SLOTOF[(size_t)r0 * N_EXPERTS + lane] : -1; if (r0 + 8 < rend) nslot2 = lane < N_EXPERTS ? SLOTOF[(size_t)(r0 + 8) * N_EXPERTS + lane] : -1;
#pragma unroll
        for (int j = 0; j < 4; ++j) { nv[j] = *(const f32x4*)(xrow(X, in, l, r0) + 4 * lane + 256 * j); nm[j] = *(const u32x2*)(MIX + (size_t)r0 * D_MODEL + 4 * lane + 256 * j); }
        LN2_LDY(nslot); } }
    for (int r = rbeg + T.wid; r < rend; r += 8) {
        float* xr = X + (size_t)r * D_MODEL; f32x4 v[4], moe[4]; u32x2 mxv[4], yv[2][4];
#pragma unroll
        for (int j = 0; j < 4; ++j) { v[j] = nv[j]; mxv[j] = nm[j]; moe[j] = (f32x4){0.f, 0.f, 0.f, 0.f}; yv[0][j] = ny[0][j]; yv[1][j] = ny[1][j]; }
        const int myslot = nslot; nslot = nslot2;
        if (r + 8 < rend) { nslot2 = (r + 16 < rend && lane < N_EXPERTS) ? SLOTOF[(size_t)(r + 16) * N_EXPERTS + lane] : -1;
#pragma unroll
            for (int j = 0; j < 4; ++j) { nv[j] = *(const f32x4*)(xrow(X, in, l, r + 8) + 4 * lane + 256 * j); nm[j] = *(const u32x2*)(MIX + (size_t)(r + 8) * D_MODEL + 4 * lane + 256 * j); }
            LN2_LDY(nslot); }
        const RLAS float* cm = cmod + (mod_set(r) == set0 ? 0 : 4 * D_MODEL);
        {
#pragma unroll
          for (int j = 0; j < 4; ++j) { const int cc = 4 * lane + 256 * j; const u32x2 w2 = mxv[j]; const f32x4 g = *(const RLAS f32x4*)(cm + cc);
              v[j][0] = alpha * v[j][0] + g[0] * blo(w2.x); v[j][1] = alpha * v[j][1] + g[1] * bhi(w2.x); v[j][2] = alpha * v[j][2] + g[2] * blo(w2.y); v[j][3] = alpha * v[j][3] + g[3] * bhi(w2.y); }
          float mean1, rstd1; ln_stats(v, mean1, rstd1, lane);
#pragma unroll
          for (int j = 0; j < 4; ++j) { const int cc = 4 * lane + 256 * j; v[j] = (v[j] - mean1) * rstd1 * *(const RLAS f32x4*)(cg + cc) + *(const RLAS f32x4*)(cg + D_MODEL + cc); } }
        unsigned long long m = __builtin_amdgcn_ballot_w64(myslot >= 0);
#pragma unroll
        for (int q = 0; q < 2; ++q) { if (m) { m &= m - 1;
#pragma unroll
            for (int j = 0; j < 4; ++j) { const u32x2 w2 = yv[q][j]; moe[j][0] += blo(w2.x); moe[j][1] += bhi(w2.x); moe[j][2] += blo(w2.y); moe[j][3] += bhi(w2.y); } } }
        while (m) { const int e = __builtin_ctzll(m); m &= m - 1; const int s = shi_idx(myslot, e); const bf16_t* ys = YS + (size_t)s * D_MODEL;
#pragma unroll
            for (int j = 0; j < 4; ++j) { const u32x2 w2 = *(const u32x2*)(ys + 4 * lane + 256 * j); moe[j][0] += blo(w2.x); moe[j][1] += bhi(w2.x); moe[j][2] += blo(w2.y); moe[j][3] += bhi(w2.y); } }
#pragma unroll
        for (int j = 0; j < 4; ++j) v[j] = alpha * v[j] + *(const RLAS f32x4*)(cm + D_MODEL + 4 * lane + 256 * j) * moe[j];
        float mean, rstd; ln_stats(v, mean, rstd, lane);
#pragma unroll
        for (int j = 0; j < 4; ++j) { const int cc = 4 * lane + 256 * j; v[j] = (v[j] - mean) * rstd * *(const RLAS f32x4*)(cg + 2 * D_MODEL + cc) + *(const RLAS f32x4*)(cg + 3 * D_MODEL + cc); }
        if (l == DEPTH - 1) {
#pragma unroll
            for (int j = 0; j < 4; ++j) *(f32x4*)(out + (size_t)r * D_MODEL + 4 * lane + 256 * j) = v[j];
            continue; }
#pragma unroll
        for (int j = 0; j < 4; ++j) __builtin_nontemporal_store(v[j], (f32x4*)(xr + 4 * lane + 256 * j));
        ln_stats(v, mean, rstd, lane);
#pragma unroll
        for (int j = 0; j < 4; ++j) { const int cc = 4 * lane + 256 * j; const f32x4 y = (v[j] - mean) * rstd * (*(const RLAS f32x4*)(cm + 3 * D_MODEL + cc) + 1.0f) + *(const RLAS f32x4*)(cm + 2 * D_MODEL + cc);
            u32x2 o; o.x = pk(y[0], y[1]); o.y = pk(y[2], y[3]); *(u32x2*)(H + (size_t)r * D_MODEL + cc) = o; } }
    __syncthreads();
#undef LN2_LDY
}
#undef RLAS
}

#define XB_TMO      128
#define XB_XCNT(j)  (256  + 64 * (j))
#define XB_XSUB(j)  (1280 + 64 * (j))
#define XB_XGEN(j)  (2304 + 64 * (j))
#define XB_TOP      3328
#define XB_TOPGEN   3392
#define XCD_BAR_WORDS 3456
#define XB_SPIN_CAP (1u << 18)
#define LAS __attribute__((address_space(3)))
__device__ __forceinline__ unsigned xb_ld(unsigned* p)              { return __hip_atomic_load(p, __ATOMIC_RELAXED, __HIP_MEMORY_SCOPE_AGENT); }
__device__ __forceinline__ unsigned xb_add(unsigned* p, unsigned v) { return __hip_atomic_fetch_add(p, v, __ATOMIC_RELAXED, __HIP_MEMORY_SCOPE_AGENT); }
__device__ __forceinline__ unsigned xb_xcc_id() { return (unsigned)__builtin_amdgcn_s_getreg((3 << 11) | 20) & 0xFu; }
#define XB_SPIN(cond, bar) do { unsigned _sp = 0; while (cond) { __builtin_amdgcn_s_sleep(1); \
    if ((++_sp & 255u) == 0u) { if (xb_ld(&(bar)[XB_TMO])) break; if (_sp > XB_SPIN_CAP) { atomicAdd(&(bar)[XB_TMO], 1u); break; } } } } while (0)
struct XcdBarrier { unsigned* bar; unsigned x; volatile LAS unsigned* st; };
__device__ __forceinline__ XcdBarrier xcd_barrier_post(unsigned* bar, volatile LAS unsigned* st) {
    XcdBarrier b; b.bar = bar; b.x = xb_xcc_id(); b.st = st;
    if (ktid() == 0) (void)xb_add(&bar[XB_XCNT(b.x)], 1u);
    return b;
}
__device__ __forceinline__ void xcd_barrier_complete(unsigned* bar, unsigned x, unsigned& nloc, unsigned& nx) {
    const unsigned G = gridDim.x * gridDim.y * gridDim.z;
    unsigned sum, cnt, mine, sp = 0u;
    for (;;) {
        sum = 0u; cnt = 0u; mine = 0u;
#pragma unroll
        for (unsigned j = 0; j < 16; ++j) { const unsigned c = xb_ld(&bar[XB_XCNT(j)]); sum += c; cnt += (c > 0u) ? 1u : 0u; mine = (j == x) ? c : mine; }
        if (sum == G) break;
        __builtin_amdgcn_s_sleep(1);
        if ((++sp & 255u) == 0u) { if (xb_ld(&bar[XB_TMO])) break; if (sp > XB_SPIN_CAP) { atomicAdd(&bar[XB_TMO], 1u); break; } }
    }
    nloc = mine > 0u ? mine : 1u; nx = cnt > 0u ? cnt : 1u;
}
__device__ __forceinline__ void xcd_barrier(const XcdBarrier& b) {
    asm volatile("s_waitcnt vmcnt(0)" ::: "memory");
    __syncthreads();
    if (ktid() == 0) {
        unsigned* bar = b.bar;
        __builtin_amdgcn_s_waitcnt(0);
        unsigned nloc = b.st[0], nx = b.st[1];
        if (nloc == 0u) { xcd_barrier_complete(bar, b.x, nloc, nx); b.st[0] = nloc; b.st[1] = nx; }
        const unsigned old = xb_add(&bar[XB_XSUB(b.x)], 1u);
        const unsigned gen = old / nloc;
        if (old + 1u == (gen + 1u) * nloc) {
            __builtin_amdgcn_fence(__ATOMIC_RELEASE, "agent");
            asm volatile("s_waitcnt vmcnt(0)" ::: "memory");
            const unsigned og = xb_add(&bar[XB_TOP], 1u);
            const unsigned tg = og / nx;
            if (og + 1u == (tg + 1u) * nx) xb_add(&bar[XB_TOPGEN], 1u);
            else XB_SPIN(xb_ld(&bar[XB_TOPGEN]) == tg, bar);
            __builtin_amdgcn_fence(__ATOMIC_ACQUIRE, "agent");
            xb_add(&bar[XB_XGEN(b.x)], 1u);
            asm volatile("s_waitcnt vmcnt(0)" ::: "memory");
        } else {
            XB_SPIN(xb_ld(&bar[XB_XGEN(b.x)]) == gen, bar);
            __builtin_amdgcn_fence(__ATOMIC_ACQUIRE, "agent");
            asm volatile("s_waitcnt vmcnt(0)" ::: "memory");
        }
    }
    __syncthreads();
}

constexpr int NWAVES = 8, NTHREADS = NWAVES * 64;
constexpr int RING_BYTES = 131072, MISC_OFF = RING_BYTES, LDS_BYTES = 147456;
constexpr int CW_Q = 2048;
constexpr int CW_BAR = 8192, BAR_STRIDE = 4096;
enum { PH_GEMM_IN = 0, PH_PREP, PH_INTRA, PH_MIX, PH_GDN_FIN, PH_BRANCH, PH_OUT, PH_LN1, PH_TOPK, PH_MOE1, PH_MOE2, PH_LN2, PPL };
constexpr int N_PHASES = 2 + DEPTH * PPL, FIN_ROWS = 64;
static_assert(NLAT % FIN_ROWS == 0 && NTOK % FIN_ROWS == 0, "GDN_FIN units");

#ifndef PROBE_REPEAT
#define PROBE_REPEAT 0u
#endif
__global__ void __launch_bounds__(NTHREADS, 2) mega_fwd(KArgs ka) {
    extern __shared__ __attribute__((aligned(16))) unsigned char lds[];
    PG8_LAS unsigned char* ring = (PG8_LAS unsigned char*)lds;
    volatile LAS unsigned* misc = (volatile LAS unsigned*)((LAS unsigned char*)lds + MISC_OFF);
    if (threadIdx.x < 64) misc[threadIdx.x] = 0u;
    if ((threadIdx.x & 63) == 0) ((volatile LAS int*)((LAS unsigned char*)lds + KTID_TAB_OFF))[(unsigned)__builtin_amdgcn_s_getreg((5 << 11) | 4) & 63u] = (int)(threadIdx.x >> 6);
    __syncthreads();
    XcdBarrier bar = xcd_barrier_post((unsigned*)ws_at(ka.ws, WSO.CTL) + CW_BAR + ka.pad * BAR_STRIDE, misc);
    const int lo = ka.i1, hi = ka.i2, G = (int)gridDim.x, c = (int)blockIdx.x;
    const float alpha = deepnorm_alpha();
#define PHASE_WS() size_t wso_ = 0; asm volatile("" : "+s"(wso_)); unsigned char* wsb_ = ka.ws + wso_
#define WSP(name, type) ((type*)ws_at(wsb_, WSO.name))
#define IN(p) (lo <= (p) && (p) < hi)
#define SEAM(p) do { if (IN(p) && IN((p) + 1)) xcd_barrier(bar); } while (0)
    if (IN(0)) { PHASE_WS(); rowp::prologue_a(wsb_, ka.in, (char*)lds, G, c); }
    SEAM(0);
    if (IN(1)) { PHASE_WS(); rowp::prologue_b(wsb_, ka.in, (char*)lds, G, c); }
    SEAM(1);
    for (int l = 0; l < DEPTH; ++l) {
        const int pb = 2 + l * PPL; const bool lastl = l == DEPTH - 1;
        for (int rep_ = 0; rep_ <= (int)((PROBE_REPEAT >> PH_GEMM_IN) & 1u); ++rep_) { if (rep_) xcd_barrier(bar); if (IN(pb + PH_GEMM_IN)) { PHASE_WS(); const SchedIn S{WSP(H, bf16_t), WSP(WinT, bf16_t) + (size_t)l * ZN * D_MODEL, G, c}; const EpiZ E{WSP(Z, bf16_t), WSP(GT, bf16_t), WSP(XS, bf16_t)}; pg8::gemm_phase(ring, D_MODEL, S, E); } }
        SEAM(pb + PH_GEMM_IN);
        for (int rep_ = 0; rep_ <= (int)((PROBE_REPEAT >> PH_PREP) & 1u); ++rep_) { if (rep_) xcd_barrier(bar); if (IN(pb + PH_PREP)) { PHASE_WS(); rowp::prep_phase(wsb_, ka.in, l, (char*)lds, G, c); } }
        SEAM(pb + PH_PREP);
        for (int rep_ = 0; rep_ <= (int)((PROBE_REPEAT >> PH_INTRA) & 1u); ++rep_) { if (rep_) xcd_barrier(bar); if (IN(pb + PH_INTRA)) { PHASE_WS(); gdn::intra_phase(wsb_, (char*)lds, G, c); } }
        SEAM(pb + PH_INTRA);
        for (int rep_ = 0; rep_ <= (int)((PROBE_REPEAT >> PH_MIX) & 1u); ++rep_) { if (rep_) xcd_barrier(bar); if (IN(pb + PH_MIX)) { PHASE_WS(); if (c < gdn::NCHAIN) { gdn::scan_chain(wsb_, c, (char*)lds);
            if (ktid() == 0) { __builtin_amdgcn_fence(__ATOMIC_RELEASE, "agent"); asm volatile("s_waitcnt vmcnt(0)" ::: "memory"); (void)xb_add(WSP(CTL, unsigned) + CW_Q + 128 * (28 + l), 1u); } } } }
        for (int rep_ = 0; rep_ <= (int)((PROBE_REPEAT >> PH_MIX) & 1u); ++rep_) { if (rep_) xcd_barrier(bar); if (IN(pb + PH_MIX)) { PHASE_WS(); attn_phase_dense(wsb_, WSP(CTL, unsigned) + CW_Q + 128 * (2 * l + rep_ * 16), lastl ? ATT_NBIG : ATT_NBIG + ATT_NSMALL, (char*)lds, G, c); attn_phase_na(wsb_, ka.in[8] + (size_t)l * B_HEADS * NA_TAB_N, WSP(CTL, unsigned) + CW_Q + 128 * (8 + l + rep_ * 4), (int)bar.x, (char*)lds, G, c); } }
        if (IN(pb + PH_MIX)) { { PHASE_WS();
            { unsigned* qf = WSP(CTL, unsigned) + CW_Q + 128 * (24 + l); unsigned* done = WSP(CTL, unsigned) + CW_Q + 128 * (28 + l);
              const int nrows_f = lastl ? NLAT : NTOK, nfin = nrows_f / FIN_ROWS; bool ready = false;
              for (;;) { const int u = claim_unit(qf, (char*)lds); if (u >= nfin) break;
                  if (!ready) { if (ktid() == 0) { unsigned sp_ = 0; while (xb_ld(done) < (unsigned)gdn::NCHAIN && ++sp_ < (1u << 24)) __builtin_amdgcn_s_sleep(2);
                                                   __builtin_amdgcn_fence(__ATOMIC_ACQUIRE, "agent"); asm volatile("s_waitcnt vmcnt(0)" ::: "memory"); }
                                __syncthreads(); ready = true; }
                  rowp::gdn_fin_rows(wsb_, ka.in, l, u * FIN_ROWS, 8, (u + 1) * FIN_ROWS); } } } }
        SEAM(pb + PH_MIX);
        for (int rep_ = 0; rep_ <= (int)((PROBE_REPEAT >> PH_BRANCH) & 1u); ++rep_) { if (rep_) xcd_barrier(bar); if (IN(pb + PH_BRANCH)) { PHASE_WS(); const SchedBranch S{WSP(OA, bf16_t), WSP(WbrT, bf16_t) + (size_t)l * N_BRANCH * D_MODEL * BRANCH_W, G, c, (lastl ? NLAT : NTOK) / BM}; const EpiBranch E{WSP(GT, bf16_t), WSP(MB, bf16_t)}; pg8::gemm_phase(ring, BRANCH_W, S, E);
            if (!lastl && c >= (NTOK / BM * (D_MODEL / BM)) % G) rowp::convert_queue(wsb_, ka.in, WSP(CTL, unsigned) + CW_Q + 128 * (44 + l), l + 1, 10, (char*)lds); } }
        SEAM(pb + PH_BRANCH);
        for (int rep_ = 0; rep_ <= (int)((PROBE_REPEAT >> PH_OUT) & 1u); ++rep_) { if (rep_) xcd_barrier(bar); if (IN(pb + PH_OUT)) { PHASE_WS(); const SchedOut S{WSP(MB, bf16_t), WSP(WoutT, bf16_t) + (size_t)l * D_MODEL * D_MODEL, G, c, (lastl ? NLAT : NTOK) / BM}; const EpiOut E{WSP(OA, bf16_t)};     pg8::gemm_phase(ring, D_MODEL, S, E);
            if (!lastl && c >= (NTOK / BM * (D_MODEL / BM)) % G) rowp::convert_queue(wsb_, ka.in, WSP(CTL, unsigned) + CW_Q + 128 * (44 + l), l + 1, 5, (char*)lds); } }
        SEAM(pb + PH_OUT);
        for (int rep_ = 0; rep_ <= (int)((PROBE_REPEAT >> PH_LN1) & 1u); ++rep_) { if (rep_) xcd_barrier(bar); if (IN(pb + PH_LN1)) { PHASE_WS(); rowp::ln1_phase(wsb_, ka.in, l, alpha, lastl ? NLAT : NTOK, (char*)lds, G, c); } }
        SEAM(pb + PH_LN1);
        for (int rep_ = 0; rep_ <= (int)((PROBE_REPEAT >> PH_TOPK) & 1u); ++rep_) { if (rep_) xcd_barrier(bar); if (IN(pb + PH_TOPK)) { PHASE_WS(); rowp::topk_phase(wsb_, (lastl ? 1 : 2) * BATCH * N_EXPERTS, (char*)lds, G, c); } }
        SEAM(pb + PH_TOPK);
        for (int rep_ = 0; rep_ <= (int)((PROBE_REPEAT >> PH_MOE1) & 1u); ++rep_) { if (rep_) xcd_barrier(bar); if (IN(pb + PH_MOE1)) { PHASE_WS(); const SchedMoe1 S{WSP(H, bf16_t), WSP(TOKLIST, int), WSP(WguT, bf16_t) + (size_t)l * N_EXPERTS * 2 * D_EXPERT * D_MODEL, G, c, (lastl ? NSLOT_L : NSLOT) / BM}; const EpiGU E{WSP(ACT, bf16_t)}; pg8::gemm_phase<EpiGU, SchedMoe1, true, true, true>(ring, D_MODEL, S, E); } }
        SEAM(pb + PH_MOE1);
        for (int rep_ = 0; rep_ <= (int)((PROBE_REPEAT >> PH_MOE2) & 1u); ++rep_) { if (rep_) xcd_barrier(bar); if (IN(pb + PH_MOE2)) { PHASE_WS(); const SchedMoe2 S{WSP(ACT, bf16_t), WSP(WdnT, bf16_t) + (size_t)l * N_EXPERTS * D_MODEL * D_EXPERT, G, c, (lastl ? NSLOT_L : NSLOT) / BM}; const EpiDown E{WSP(GATEV, float), WSP(YS, bf16_t)}; pg8::gemm_phase(ring, D_EXPERT, S, E);
            if (!lastl && c >= (NSLOT / BM * (D_MODEL / BM)) % G) rowp::convert_queue(wsb_, ka.in, WSP(CTL, unsigned) + CW_Q + 128 * (44 + l), l + 1, 5, (char*)lds); } }
        SEAM(pb + PH_MOE2);
        for (int rep_ = 0; rep_ <= (int)((PROBE_REPEAT >> PH_LN2) & 1u); ++rep_) { if (rep_) xcd_barrier(bar); if (IN(pb + PH_LN2)) { PHASE_WS(); rowp::ln2_phase(wsb_, ka.in, ka.out, l, alpha, (char*)lds, G, c);
            if (!lastl) rowp::convert_queue(wsb_, ka.in, WSP(CTL, unsigned) + CW_Q + 128 * (44 + l), l + 1, -1, (char*)lds); } }
        SEAM(pb + PH_LN2);
    }
#undef IN
#undef SEAM
}

#ifndef MK_CUTS
#define MK_CUTS 0
#endif
extern "C" void kernel_launch(void* const* d_in, const int* in_sizes, int n_in, void* d_out, int out_size, void* d_ws, size_t ws_size, hipStream_t stream) {
    static int grid = 0;
    if (grid == 0) {
        int dev = 0, cus = 0, per_cu = 0;
        if (hipGetDevice(&dev) != hipSuccess || hipDeviceGetAttribute(&cus, hipDeviceAttributeMultiprocessorCount, dev) != hipSuccess) { fprintf(stderr, "kernel_launch: device query failed\n"); grid = -1; return; }
        if (hipFuncSetAttribute((const void*)mega_fwd, hipFuncAttributeMaxDynamicSharedMemorySize, LDS_BYTES) != hipSuccess) { fprintf(stderr, "kernel_launch: hipFuncSetAttribute failed\n"); grid = -1; return; }
        if (hipOccupancyMaxActiveBlocksPerMultiprocessor(&per_cu, (const void*)mega_fwd, NTHREADS, LDS_BYTES) != hipSuccess || per_cu < 1) fprintf(stderr, "kernel_launch: occupancy query reports %d\n", per_cu);
        (void)hipGetLastError();
        grid = cus;
    }
    if (grid < 0) return;
    KArgs ka; memset(&ka, 0, sizeof ka);
    for (int i = 0; i < 22; ++i) ka.in[i] = (const float*)d_in[i];
    const size_t need = WSO.total; ka.ws = (unsigned char*)d_ws;
    if (need > ws_size) { fprintf(stderr, "workspace too small: need %zu have %zu\n", need, ws_size); return; }
    ka.out = (float*)d_out;
    (void)hipMemsetAsync(ka.ws + WSO.CTL, 0, 1 << 20, stream);
    int n_mega = 0;
    auto mega = [&](int lo, int hi) { KArgs a = ka; a.i1 = lo; a.i2 = hi; a.pad = n_mega++; hipLaunchKernelGGL(mega_fwd, dim3(grid), dim3(NTHREADS), LDS_BYTES, stream, a); };
    if (MK_CUTS == 0) mega(0, N_PHASES);
    else for (int p = 0; p < N_PHASES; p += MK_CUTS) mega(p, p + MK_CUTS < N_PHASES ? p + MK_CUTS : N_PHASES);
    const hipError_t le = hipPeekAtLastError();
    if (le != hipSuccess) fprintf(stderr, "kernel_launch: launch failed: %s\n", hipGetErrorName(le));
}
#endif

#ifdef HOST_TEST
#include <vector>
#include <cstdlib>
#define RUN(k) k(ka, ka.l, ka.i1, ka.i2)
int main(int argc, char** argv) {
    const char* dir = argc > 1 ? argv[1] : ".";
    const size_t sizes[22] = {(size_t)NLAT * D_MODEL, (size_t)BATCH * D_MODEL, (size_t)NCTX * D_MODEL, (size_t)D_MODEL, (size_t)DEPTH * D_MODEL * N_MOD * D_MODEL, (size_t)DEPTH * N_MOD * D_MODEL,
        (size_t)DEPTH * D_MODEL * D_IN, (size_t)DEPTH * 2 * HD, (size_t)DEPTH * B_HEADS * (2 * NA_ROWS - 1) * (2 * NA_COLS - 1), (size_t)DEPTH * CONV_K * 3 * C_W, (size_t)DEPTH * 2 * C_HEADS, (size_t)DEPTH * 2 * C_HEADS,
        (size_t)DEPTH * HD, (size_t)DEPTH * N_BRANCH * BRANCH_W * D_MODEL, (size_t)DEPTH * D_MODEL * D_MODEL, (size_t)DEPTH * D_MODEL, (size_t)DEPTH * D_MODEL, (size_t)DEPTH * D_MODEL * N_EXPERTS,
        (size_t)DEPTH * N_EXPERTS * D_MODEL * 2 * D_EXPERT, (size_t)DEPTH * N_EXPERTS * D_EXPERT * D_MODEL, (size_t)DEPTH * D_MODEL, (size_t)DEPTH * D_MODEL};
    std::vector<std::vector<float>> bufs(22); char path[512]; snprintf(path, sizeof path, "%s/inputs.bin", dir);
    FILE* f = fopen(path, "rb"); if (!f) { perror(path); return 1; }
    for (int i = 0; i < 22; ++i) { bufs[i].resize(sizes[i]); if (fread(bufs[i].data(), 4, sizes[i], f) != sizes[i]) { fprintf(stderr, "short read input %d\n", i); return 1; } }
    fclose(f);
    const float* p[22]; for (int i = 0; i < 22; ++i) p[i] = bufs[i].data();
    Inputs in{p[0], p[1], p[2], p[3], p[4], p[5], p[6], p[7], p[8], p[9], p[10], p[11], p[12], p[13], p[14], p[15], p[16], p[17], p[18], p[19], p[20], p[21]};
    std::vector<unsigned char> wsbuf(WSO.total, 0xAA); WS w = make_ws(wsbuf.data());
    std::vector<float> out((size_t)NLAT * D_MODEL);
    KArgs ka; memset(&ka, 0, sizeof ka); for (int i = 0; i < 22; ++i) ka.in[i] = p[i]; ka.ws = wsbuf.data(); ka.out = out.data();
    RUN(p_prep_weights); RUN(p_mod_init); ka.l = 0; ka.i1 = 0; ka.i2 = 1; RUN(p_ln_mod);
    auto cmp = [&](const char* name, auto get, size_t n) { snprintf(path, sizeof path, "%s/dbg_%s.bin", dir, name); FILE* g = fopen(path, "rb"); if (!g) return; std::vector<float> ref(n); size_t got = fread(ref.data(), 4, n, g); fclose(g);
        if (got != n) { printf("  %s: size mismatch %zu vs %zu\n", name, got, n); return; } double se = 0, sr = 0, mx = 0; for (size_t i = 0; i < n; ++i) { const double d = (double)get(i) - ref[i]; se += d * d; sr += (double)ref[i] * ref[i]; if (fabs(d) > mx) mx = fabs(d); }
        printf("  %-8s rvr=%.3e absmax=%.3e (ref rms %.3e)\n", name, se / sr, mx, sqrt(sr / n)); };
    for (int l = 0; l < DEPTH; ++l) {
        ka.l = l; RUN(p_gemm_in_naive); RUN(p_prep_a); RUN(p_prep_c);
        RUN(p_attn_a_naive); RUN(p_attn_b_naive); RUN(p_gdn_naive); RUN(p_gdn_fin);
        if (l == 0) { cmp("o_a", [&](size_t i) { return bf2f(w.OA[i]); }, (size_t)NLAT * BRANCH_W); cmp("o_b", [&](size_t i) { return bf2f(w.OB[i]); }, (size_t)NLAT * BRANCH_W); cmp("o_c", [&](size_t i) { return bf2f(w.OC[i]); }, (size_t)NLAT * BRANCH_W);
            cmp("o_a_x", [&](size_t i) { return bf2f(w.OA[(size_t)NLAT * BRANCH_W + i]); }, (size_t)NCTX * BRANCH_W); cmp("o_b_x", [&](size_t i) { return bf2f(w.OB[(size_t)NLAT * BRANCH_W + i]); }, (size_t)NCTX * BRANCH_W);
            cmp("o_c_x", [&](size_t i) { return bf2f(w.OC[(size_t)NLAT * BRANCH_W + i]); }, (size_t)NCTX * BRANCH_W); }
        RUN(p_branch_naive); RUN(p_out_naive); RUN(p_ln1_router);
        if (l == 0) cmp("x1", [&](size_t i) { return w.X[i]; }, (size_t)NLAT * D_MODEL);
        RUN(p_topk_naive); RUN(p_moe1_naive); RUN(p_moe2_naive); RUN(p_ln2);
        if (l == 0) { cmp("x2", [&](size_t i) { return w.X[i]; }, (size_t)NLAT * D_MODEL); cmp("ctx2", [&](size_t i) { return w.X[(size_t)NLAT * D_MODEL + i]; }, (size_t)NCTX * D_MODEL); }
    }
    snprintf(path, sizeof path, "%s/ref_out.bin", dir); f = fopen(path, "rb"); std::vector<float> ref(out.size()); if (fread(ref.data(), 4, ref.size(), f) != ref.size()) return 1; fclose(f);
    double se = 0, sr = 0, mx = 0; for (size_t i = 0; i < out.size(); ++i) { const double d = (double)out[i] - ref[i]; se += d * d; sr += (double)ref[i] * ref[i]; if (fabs(d) > mx) mx = fabs(d); }
    printf("FINAL rvr=%.3e absmax=%.3e\n", se / sr, mx);
    return 0;
}
#endif
```

```cpp
#ifndef HOST_TEST
#include <hip/hip_runtime.h>
#endif
#include <cstdio>
#include <cstdint>
#include <cstring>
#include <cmath>

#ifndef CFG_SMALL
constexpr int D_MODEL = 1024, BATCH = 8, SEQ = 4096, DEPTH = 4, GRID_W = 64, CTX_LEN = 256;
constexpr int A_HEADS = 8, A_KV_HEADS = 2, HD = 64;
constexpr int B_HEADS = 8, NA_ROWS = 8, NA_COLS = 16;
constexpr int C_HEADS = 8, CONV_K = 4;
constexpr int N_EXPERTS = 16, D_EXPERT = 2048, CAPACITY = 2;
#else
constexpr int D_MODEL = 128, BATCH = 2, SEQ = CFG_SEQ, DEPTH = 2, GRID_W = CFG_GRID_W, CTX_LEN = 64;
constexpr int A_HEADS = 4, A_KV_HEADS = 2, HD = 16;
constexpr int B_HEADS = 4, NA_ROWS = 8, NA_COLS = 16;
constexpr int C_HEADS = 4, CONV_K = 4;
constexpr int N_EXPERTS = 4, D_EXPERT = 64, CAPACITY = 2;
#endif
constexpr int N_BRANCH = 3, BRANCH_W = A_HEADS * HD, N_MOD = 6;
constexpr float LN_EPS = 1e-6f, ROPE_THETA = 10000.0f;
constexpr int A_Q_W = A_HEADS * HD, A_KV_W = A_KV_HEADS * HD, B_W = B_HEADS * HD, C_W = C_HEADS * HD;
constexpr int D_IN = A_Q_W + 2 * A_KV_W + 3 * B_W + 3 * C_W + C_W + 4 * C_HEADS + N_BRANCH * D_MODEL;
static_assert(B_W == BRANCH_W && C_W == BRANCH_W, "branch widths");
constexpr int OC_QA = 0, OC_KA = OC_QA + A_Q_W, OC_VA = OC_KA + A_KV_W, OC_QB = OC_VA + A_KV_W, OC_KB = OC_QB + B_W, OC_VB = OC_KB + B_W,
              OC_QKVC = OC_VB + B_W, OC_GC = OC_QKVC + 3 * C_W, OC_A = OC_GC + C_W, OC_B = OC_A + 2 * C_HEADS, OC_MG = OC_B + 2 * C_HEADS;
static_assert(OC_MG + N_BRANCH * D_MODEL == D_IN, "D_IN");
constexpr int ZC_QA = OC_QA, ZC_KA = OC_KA, ZC_VA = OC_VA, ZC_QB = OC_QB, ZC_KB = OC_KB, ZC_VB = OC_VB, ZC_QKVC = OC_QKVC, ZC_GC = OC_GC, ZC_A = OC_A, ZC_B = OC_B;
constexpr int ZC_MG = (OC_MG + 255) / 256 * 256, ZN = ZC_MG + N_BRANCH * D_MODEL;
constexpr int NLAT = BATCH * SEQ, NCTX = BATCH * CTX_LEN, NTOK = NLAT + NCTX, KVLEN = SEQ + CTX_LEN;
constexpr size_t KVB_BYTES = (size_t)BATCH * B_HEADS * KVLEN * HD * 2;
constexpr int CAP_L = CAPACITY * SEQ / N_EXPERTS, CAP_C = CAPACITY * CTX_LEN / N_EXPERTS;
constexpr int NSLOT_L = BATCH * N_EXPERTS * CAP_L, NSLOT_C = BATCH * N_EXPERTS * CAP_C, NSLOT = NSLOT_L + NSLOT_C;
constexpr int GU_BLK = D_EXPERT >= 128 ? 128 : D_EXPERT;
constexpr int GRID_H = SEQ / GRID_W, WIN_R = NA_ROWS < GRID_H ? NA_ROWS : GRID_H;
constexpr int NFREQ = HD / 4, ROPE_P = GRID_H > GRID_W ? GRID_H : GRID_W;
constexpr float LOG2E = 1.4426950408889634f;
#ifndef CFG_SMALL
constexpr float QSCALE = 0.125f * LOG2E;
#else
constexpr float QSCALE = 0.25f * LOG2E;
#endif

typedef unsigned short bf16_t;

#ifdef HOST_TEST
#define HD_FN inline
#define GLOBAL_FN static
#define UNROLL
struct Dim3H { int x; };
static Dim3H threadIdx{0}, blockIdx{0}, blockDim{1}, gridDim{1};
#else
#define HD_FN __host__ __device__ __forceinline__
#define GLOBAL_FN __device__ __forceinline__
#define UNROLL _Pragma("unroll")
#endif
#define GSTRIDE_LOOP(i, n) for (long i = (long)blockIdx.x * blockDim.x + threadIdx.x; i < (long)(n); i += (long)gridDim.x * blockDim.x)

HD_FN float bf2f(bf16_t v) { unsigned u = (unsigned)v << 16; float f; memcpy(&f, &u, 4); return f; }
HD_FN bf16_t f2bf(float f) { unsigned u; memcpy(&u, &f, 4); u += 0x7fffu + ((u >> 16) & 1u); return (bf16_t)(u >> 16); }
HD_FN float siluf(float x) { return x / (1.0f + expf(-x)); }
HD_FN float sigmoidf(float x) { return 1.0f / (1.0f + expf(-x)); }
HD_FN float softplusf(float x) { return x > 20.f ? x : log1pf(expf(x)); }
HD_FN void sincos_rr(float x, float& s, float& c) {
#ifdef HOST_TEST
    s = sinf(x); c = cosf(x);
#else
    const float k = rintf(x * 0.15915494309189535f); float r = fmaf(-k, 6.28318548202514648f, x); r = fmaf(-k, -1.7484555e-7f, r);
    s = __sinf(r); c = __cosf(r);
#endif
}
HD_FN int clampi(int v, int lo, int hi) { return v < lo ? lo : (v > hi ? hi : v); }
HD_FN int zcol2orig(int n) { return n < OC_MG ? n : (n < ZC_MG ? -1 : n - (ZC_MG - OC_MG)); }
HD_FN int gu_row(int half, int c) { return (c / GU_BLK) * (2 * GU_BLK) + half * GU_BLK + (c % GU_BLK); }
HD_FN int mod_set(int r) { return r < NLAT ? r / SEQ : BATCH; }
HD_FN int slot_expert(int s) { return s < NSLOT_L ? s / (BATCH * CAP_L) : (s - NSLOT_L) / (BATCH * CAP_C); }

struct WS {
    bf16_t *WinT, *WbrT, *WoutT, *WguT, *WdnT;
    float *MOD;
    float *ROPE;
    float *X;
    bf16_t *H;
    bf16_t *Z;
    bf16_t *QA;
    bf16_t *KA, *VA;
    bf16_t *QC, *KC, *VC;
    unsigned char *GOP;
    float *SDEC;
    float *G, *BETA;
    float *OCD;
    bf16_t *OA, *OB, *OC;
    bf16_t *MB;
    bf16_t *GT;
    float *AFF;
    int *TOKLIST;
    float *GATEV;
    int *SLOTOF;
    bf16_t *XS;
    bf16_t *ACT;
    bf16_t *YS;
    unsigned *CTL;
};
struct Inputs {
    const float *x, *c, *ctx, *c_ctx, *w_mod, *b_mod, *w_in, *qk_gain, *rpb, *conv_w, *a_log, *dt_bias, *o_gain, *w_branch, *w_out,
        *ln1_g, *ln1_b, *w_router, *w_gate_up, *w_down, *ln2_g, *ln2_b;
};
struct KArgs { const float* in[22]; unsigned char* ws; float* out; int l, i1, i2, pad; };
HD_FN Inputs make_inputs(const KArgs& ka) { const float* const* p = ka.in;
    return Inputs{p[0], p[1], p[2], p[3], p[4], p[5], p[6], p[7], p[8], p[9], p[10], p[11], p[12], p[13], p[14], p[15], p[16], p[17], p[18], p[19], p[20], p[21]}; }
struct WSOff { size_t GT, CTL, WinT, WbrT, WoutT, WguT, WdnT, MOD, ROPE, X, H, Z, QA, KA, VA, QC, KC, VC, GOP, SDEC, G, BETA, OCD, OA, OB, OC, MB, AFF, TOKLIST, GATEV, SLOTOF, XS, ACT, YS, total; };
constexpr size_t al256(size_t b) { return (b + 255) / 256 * 256; }
constexpr WSOff ws_offsets() {
    WSOff o{}; size_t off = 0;
#define TAKE(name, bytes) o.name = off; off += al256((size_t)(bytes));
    TAKE(CTL, 1 << 20)
    TAKE(WinT, (size_t)DEPTH * ZN * D_MODEL * 2) TAKE(WbrT, (size_t)DEPTH * N_BRANCH * D_MODEL * BRANCH_W * 2) TAKE(WoutT, (size_t)DEPTH * D_MODEL * D_MODEL * 2)
    TAKE(WguT, (size_t)DEPTH * N_EXPERTS * 2 * D_EXPERT * D_MODEL * 2) TAKE(WdnT, (size_t)DEPTH * N_EXPERTS * D_MODEL * D_EXPERT * 2)
    TAKE(MOD, (size_t)DEPTH * (BATCH + 1) * N_MOD * D_MODEL * 4) TAKE(ROPE, (size_t)ROPE_P * NFREQ * 2 * 4)
    TAKE(X, (size_t)NTOK * D_MODEL * 4) TAKE(H, (size_t)NTOK * D_MODEL * 2) TAKE(Z, (size_t)NTOK * ZN * 2) TAKE(QA, (size_t)NTOK * A_Q_W * 2)
    TAKE(KA, (size_t)BATCH * KVLEN * A_KV_W * 2) TAKE(VA, (size_t)BATCH * KVLEN * A_KV_W * 2)
    TAKE(QC, (size_t)NTOK * C_W * 2) TAKE(KC, (size_t)NTOK * C_W * 2) TAKE(VC, (size_t)NTOK * C_W * 2)
    TAKE(GOP, (size_t)2 * BATCH * C_HEADS * (KVLEN / 64) * 41984) TAKE(SDEC, (size_t)2 * BATCH * C_HEADS * (KVLEN / 64) * 4) TAKE(G, (size_t)NTOK * 2 * C_HEADS * 4) TAKE(BETA, (size_t)NTOK * 2 * C_HEADS * 4)
    TAKE(OCD, (size_t)2 * NTOK * C_W * 4) TAKE(OA, (size_t)NTOK * BRANCH_W * 2) TAKE(OB, (size_t)NTOK * BRANCH_W * 2) TAKE(OC, (size_t)NTOK * BRANCH_W * 2) TAKE(MB, (size_t)NTOK * D_MODEL * 2) TAKE(GT, (size_t)NTOK * N_BRANCH * D_MODEL * 2)
    TAKE(AFF, (size_t)NTOK * N_EXPERTS * 4) TAKE(TOKLIST, (size_t)NSLOT * 4) TAKE(GATEV, (size_t)NSLOT * 4) TAKE(SLOTOF, (size_t)NTOK * N_EXPERTS * 4)
    TAKE(XS, (size_t)NSLOT * D_MODEL * 2) TAKE(ACT, (size_t)NSLOT * D_EXPERT * 2) TAKE(YS, (size_t)NSLOT * D_MODEL * 2)
#undef TAKE
    o.total = off; return o;
}
constexpr WSOff WSO = ws_offsets();
HD_FN unsigned char* ws_at(unsigned char* b, size_t off) {
#if defined(__HIP_DEVICE_COMPILE__)
    unsigned lo = (unsigned)off; asm volatile("" : "+s"(lo)); return b + (size_t)lo + ((off >> 32) << 32);
#else
    return b + off;
#endif
}
HD_FN WS make_ws(unsigned char* b) { WS w;
#define SETP(name, type) w.name = (type*)ws_at(b, WSO.name);
    SETP(CTL, unsigned) SETP(WinT, bf16_t) SETP(WbrT, bf16_t) SETP(WoutT, bf16_t) SETP(WguT, bf16_t) SETP(WdnT, bf16_t) SETP(MOD, float) SETP(ROPE, float) SETP(X, float) SETP(H, bf16_t) SETP(Z, bf16_t)
    SETP(QA, bf16_t) SETP(KA, bf16_t) SETP(VA, bf16_t) SETP(QC, bf16_t) SETP(KC, bf16_t) SETP(VC, bf16_t) SETP(GOP, unsigned char) SETP(SDEC, float) SETP(G, float) SETP(BETA, float) SETP(OCD, float) SETP(OA, bf16_t) SETP(OB, bf16_t) SETP(OC, bf16_t)
    SETP(MB, bf16_t) SETP(GT, bf16_t) SETP(AFF, float) SETP(TOKLIST, int) SETP(GATEV, float) SETP(SLOTOF, int) SETP(XS, bf16_t) SETP(ACT, bf16_t) SETP(YS, bf16_t)
#undef SETP
    return w; }


GLOBAL_FN void p_prep_weights(const KArgs& ka, const int l = 0, const int sh = 0, const int sc = 0) { const Inputs in = make_inputs(ka); const WS w = make_ws(ka.ws); (void)ka; (void)l; (void)sh; (void)sc;
    GSTRIDE_LOOP(i, (long)DEPTH * ZN * D_MODEL) {
        const int k = (int)(i % D_MODEL); const long t = i / D_MODEL; const int n = (int)(t % ZN), l = (int)(t / ZN);
        const int o = zcol2orig(n);
        w.WinT[i] = o >= 0 ? f2bf(in.w_in[((size_t)l * D_MODEL + k) * D_IN + o]) : (bf16_t)0;
    }
    GSTRIDE_LOOP(i, (long)DEPTH * N_BRANCH * D_MODEL * BRANCH_W) {
        const int k = (int)(i % BRANCH_W); const long t = i / BRANCH_W; const int n = (int)(t % D_MODEL); const long lb = t / D_MODEL;
        w.WbrT[i] = f2bf(in.w_branch[((size_t)lb * BRANCH_W + k) * D_MODEL + n]);
    }
    GSTRIDE_LOOP(i, (long)DEPTH * D_MODEL * D_MODEL) {
        const int k = (int)(i % D_MODEL); const long t = i / D_MODEL; const int n = (int)(t % D_MODEL), l = (int)(t / D_MODEL);
        w.WoutT[i] = f2bf(in.w_out[((size_t)l * D_MODEL + k) * D_MODEL + n]);
    }
    GSTRIDE_LOOP(i, (long)DEPTH * N_EXPERTS * 2 * D_EXPERT * D_MODEL) {
        const int k = (int)(i % D_MODEL); const long t = i / D_MODEL; const int row = (int)(t % (2 * D_EXPERT)); const long le = t / (2 * D_EXPERT);
        const int blk = row / (2 * GU_BLK), rem = row % (2 * GU_BLK), half = rem / GU_BLK, c = blk * GU_BLK + rem % GU_BLK;
        w.WguT[i] = f2bf(in.w_gate_up[((size_t)le * D_MODEL + k) * (2 * D_EXPERT) + half * D_EXPERT + c]);
    }
    GSTRIDE_LOOP(i, (long)DEPTH * N_EXPERTS * D_MODEL * D_EXPERT) {
        const int k = (int)(i % D_EXPERT); const long t = i / D_EXPERT; const int n = (int)(t % D_MODEL); const long le = t / D_MODEL;
        w.WdnT[i] = f2bf(in.w_down[((size_t)le * D_EXPERT + k) * D_MODEL + n]);
    }
}

GLOBAL_FN void p_mod_init(const KArgs& ka, const int l = 0, const int sh = 0, const int sc = 0) { const Inputs in = make_inputs(ka); const WS w = make_ws(ka.ws); (void)ka; (void)l; (void)sh; (void)sc;
    GSTRIDE_LOOP(i, (long)DEPTH * (BATCH + 1) * N_MOD * D_MODEL) {
        const int j = (int)(i % (N_MOD * D_MODEL)); const long t = i / (N_MOD * D_MODEL); const int s = (int)(t % (BATCH + 1)), l = (int)(t / (BATCH + 1));
        const float* cv = s < BATCH ? in.c + (size_t)s * D_MODEL : in.c_ctx;
        float acc = 0.f;
        for (int k = 0; k < D_MODEL; ++k) acc += siluf(cv[k]) * in.w_mod[((size_t)l * D_MODEL + k) * (N_MOD * D_MODEL) + j];
        w.MOD[i] = acc + in.b_mod[(size_t)l * N_MOD * D_MODEL + j];
    }
    GSTRIDE_LOOP(i, (long)NTOK * D_MODEL) w.X[i] = i < (long)NLAT * D_MODEL ? in.x[i] : in.ctx[i - (long)NLAT * D_MODEL];
    GSTRIDE_LOOP(i, (long)ROPE_P * NFREQ) { const int f = (int)(i % NFREQ), p = (int)(i / NFREQ); const float inv = exp2f(-(float)f / NFREQ * 13.287712379549449f);
        float s, c; sincos_rr((float)p * inv, s, c); w.ROPE[2 * i] = c; w.ROPE[2 * i + 1] = s; }
}

HD_FN const float* modp(const WS& w, int l, int r, int which) { return w.MOD + (((size_t)l * (BATCH + 1) + mod_set(r)) * N_MOD + which) * D_MODEL; }

GLOBAL_FN void p_ln_mod(const KArgs& ka, const int l = 0, const int sh = 0, const int sc = 0) { const WS w = make_ws(ka.ws);    (void)ka; (void)l; (void)sh; (void)sc;
    GSTRIDE_LOOP(r, NTOK) {
        const float* x = w.X + (size_t)r * D_MODEL; float mu = 0.f, var = 0.f;
        for (int c = 0; c < D_MODEL; ++c) mu += x[c];
        mu /= D_MODEL;
        for (int c = 0; c < D_MODEL; ++c) { const float d = x[c] - mu; var += d * d; }
        const float rs = 1.0f / sqrtf(var / D_MODEL + LN_EPS);
        const float *ms = modp(w, l, (int)r, sh), *mc = modp(w, l, (int)r, sc);
        for (int c = 0; c < D_MODEL; ++c) w.H[(size_t)r * D_MODEL + c] = f2bf((x[c] - mu) * rs * (1.0f + mc[c]) + ms[c]);
    }
}

HD_FN float dot_bf(const bf16_t* a, const bf16_t* b, int K) { float s = 0.f; for (int k = 0; k < K; ++k) s += bf2f(a[k]) * bf2f(b[k]); return s; }

GLOBAL_FN void p_gemm_in_naive(const KArgs& ka, const int l = 0, const int sh = 0, const int sc = 0) { const WS w = make_ws(ka.ws);  (void)ka; (void)l; (void)sh; (void)sc;
    GSTRIDE_LOOP(i, (long)NTOK * ZN) { const int n = (int)(i % ZN); const long r = i / ZN;
        const float zv = dot_bf(w.H + (size_t)r * D_MODEL, w.WinT + ((size_t)l * ZN + n) * D_MODEL, D_MODEL) * ((n >= ZC_QB && n < ZC_QB + B_W) ? QSCALE : 1.0f);
        w.Z[i] = f2bf(n >= ZC_MG ? sigmoidf(zv) : zv); }
}

GLOBAL_FN void p_prep_a(const KArgs& ka, const int l = 0, const int sh = 0, const int sc = 0) { const Inputs in = make_inputs(ka); const WS w = make_ws(ka.ws);  (void)ka; (void)l; (void)sh; (void)sc;
    GSTRIDE_LOOP(i, (long)NTOK * (A_HEADS + 2 * A_KV_HEADS)) {
        const int hh = (int)(i % (A_HEADS + 2 * A_KV_HEADS)); const int r = (int)(i / (A_HEADS + 2 * A_KV_HEADS));
        const bool lat = r < NLAT; const int b = lat ? r / SEQ : (r - NLAT) / CTX_LEN, t = lat ? r % SEQ : (r - NLAT) % CTX_LEN;
        const size_t kvrow = (size_t)b * KVLEN + (lat ? t : SEQ + t);
        if (hh >= A_HEADS + A_KV_HEADS) { const int kvh = hh - A_HEADS - A_KV_HEADS;
            UNROLL for (int d = 0; d < HD; ++d) w.VA[kvrow * A_KV_W + kvh * HD + d] = w.Z[(size_t)r * ZN + ZC_VA + kvh * HD + d];
            continue; }
        const bool isq = hh < A_HEADS; const int hq = isq ? hh : hh - A_HEADS;
        const bf16_t* src = w.Z + (size_t)r * ZN + (isq ? ZC_QA : ZC_KA) + hq * HD;
        const float* gain = in.qk_gain + ((size_t)l * 2 + (isq ? 0 : 1)) * HD;
        float v[HD]; float ss = 0.f;
        UNROLL for (int d = 0; d < HD; ++d) { v[d] = bf2f(src[d]); ss += v[d] * v[d]; }
        const float rs = 1.0f / sqrtf(ss / HD + LN_EPS);
        UNROLL for (int d = 0; d < HD; ++d) v[d] = v[d] * rs * gain[d];
        if (lat) { const float* tr = w.ROPE + (size_t)(t / GRID_W) * NFREQ * 2; const float* tc = w.ROPE + (size_t)(t % GRID_W) * NFREQ * 2;
            UNROLL for (int f = 0; f < NFREQ; ++f) { const float cr = tr[2 * f], sr = tr[2 * f + 1], cc = tc[2 * f], sc = tc[2 * f + 1];
                const float x1 = v[f], x2 = v[NFREQ + f], x3 = v[2 * NFREQ + f], x4 = v[3 * NFREQ + f];
                v[f] = x1 * cr - x2 * sr; v[NFREQ + f] = x2 * cr + x1 * sr; v[2 * NFREQ + f] = x3 * cc - x4 * sc; v[3 * NFREQ + f] = x4 * cc + x3 * sc; } }
        if (isq) { UNROLL for (int d = 0; d < HD; ++d) w.QA[(size_t)r * A_Q_W + hq * HD + d] = f2bf(v[d] * QSCALE); }
        else UNROLL for (int d = 0; d < HD; ++d) w.KA[kvrow * A_KV_W + hq * HD + d] = f2bf(v[d]);
    }
}

GLOBAL_FN void p_prep_c(const KArgs& ka, const int l = 0, const int sh = 0, const int sc = 0) { const Inputs in = make_inputs(ka); const WS w = make_ws(ka.ws);  (void)ka; (void)l; (void)sh; (void)sc;
    GSTRIDE_LOOP(i, (long)NTOK * C_HEADS) {
        const int h = (int)(i % C_HEADS); const int r = (int)(i / C_HEADS);
        const bool lat = r < NLAT; const int t = lat ? r % SEQ : (r - NLAT) % CTX_LEN, len = lat ? SEQ : CTX_LEN;
        UNROLL for (int part = 0; part < 3; ++part) {
            float v[HD]; float ss = 0.f;
            UNROLL for (int d = 0; d < HD; ++d) { const int ch = part * C_W + h * HD + d; float y = 0.f;
                for (int j = 0; j < CONV_K; ++j) { const int tt = t + j - CONV_K / 2; if (tt >= 0 && tt < len) y += bf2f(w.Z[(size_t)(r + tt - t) * ZN + ZC_QKVC + ch]) * in.conv_w[((size_t)l * CONV_K + j) * (3 * C_W) + ch]; }
                v[d] = siluf(y); ss += v[d] * v[d]; }
            float sc = 1.f; if (part < 2) sc = 1.0f / sqrtf(ss + LN_EPS); if (part == 0) sc *= 1.0f / sqrtf((float)HD);
            bf16_t* dst = (part == 0 ? w.QC : part == 1 ? w.KC : w.VC) + (size_t)r * C_W + h * HD;
            UNROLL for (int d = 0; d < HD; ++d) dst[d] = f2bf(v[d] * sc);
        }
        for (int dir = 0; dir < 2; ++dir) {
            const float a = bf2f(w.Z[(size_t)r * ZN + ZC_A + dir * C_HEADS + h]), bt = bf2f(w.Z[(size_t)r * ZN + ZC_B + dir * C_HEADS + h]);
            w.G[((size_t)r * 2 + dir) * C_HEADS + h] = -expf(in.a_log[((size_t)l * 2 + dir) * C_HEADS + h]) * softplusf(a + in.dt_bias[((size_t)l * 2 + dir) * C_HEADS + h]);
            w.BETA[((size_t)r * 2 + dir) * C_HEADS + h] = sigmoidf(bt);
        }
    }
}

GLOBAL_FN void p_attn_a_naive(const KArgs& ka, const int l = 0, const int sh = 0, const int sc = 0) { const WS w = make_ws(ka.ws); (void)ka; (void)l; (void)sh; (void)sc;
    GSTRIDE_LOOP(i, (long)NTOK * A_HEADS) {
        const int h = (int)(i % A_HEADS); const int r = (int)(i / A_HEADS);
        const bool lat = r < NLAT; const int b = lat ? r / SEQ : (r - NLAT) / CTX_LEN;
        const int kvh = h / (A_HEADS / A_KV_HEADS), m0 = lat ? 0 : SEQ;
        float q[HD], o[HD]; UNROLL for (int d = 0; d < HD; ++d) { q[d] = bf2f(w.QA[(size_t)r * A_Q_W + h * HD + d]); o[d] = 0.f; }
        float mx = -INFINITY, lsum = 0.f;
        for (int m = m0; m < KVLEN; ++m) {
            const bf16_t* kp = w.KA + ((size_t)b * KVLEN + m) * A_KV_W + kvh * HD; const bf16_t* vp = w.VA + ((size_t)b * KVLEN + m) * A_KV_W + kvh * HD;
            float s = 0.f; UNROLL for (int d = 0; d < HD; ++d) s += q[d] * bf2f(kp[d]);
            const float nm = s > mx ? s : mx, f = exp2f(mx - nm), p = exp2f(s - nm);
            lsum = lsum * f + p; UNROLL for (int d = 0; d < HD; ++d) o[d] = o[d] * f + p * bf2f(vp[d]); mx = nm;
        }
        UNROLL for (int d = 0; d < HD; ++d) w.OA[(size_t)r * BRANCH_W + h * HD + d] = f2bf(o[d] / lsum);
    }
}

GLOBAL_FN void p_attn_b_naive(const KArgs& ka, const int l = 0, const int sh = 0, const int sc = 0) { const Inputs in = make_inputs(ka); const WS w = make_ws(ka.ws);  (void)ka; (void)l; (void)sh; (void)sc;
    GSTRIDE_LOOP(i, (long)(sh ? NLAT : NTOK) * B_HEADS) {
        const int h = (int)(i % B_HEADS); const int r = (int)(i / B_HEADS);
        const bool lat = r < NLAT; const int b = lat ? r / SEQ : (r - NLAT) / CTX_LEN, t = lat ? r % SEQ : 0;
        float q[HD], o[HD]; UNROLL for (int d = 0; d < HD; ++d) { q[d] = bf2f(w.Z[(size_t)r * ZN + ZC_QB + h * HD + d]); o[d] = 0.f; }
        float mx = -INFINITY, lsum = 0.f;
        const int row = t / GRID_W, col = t % GRID_W, rs = clampi(row - WIN_R / 2, 0, GRID_H - WIN_R), cs = clampi(col - NA_COLS / 2, 0, GRID_W - NA_COLS);
        const int nnb = lat ? WIN_R * NA_COLS : 0;
        for (int m = 0; m < nnb + CTX_LEN; ++m) {
            size_t krow; float bias = 0.f;
            if (m < nnb) { const int kr = rs + m / NA_COLS, kc = cs + m % NA_COLS; krow = (size_t)b * SEQ + kr * GRID_W + kc;
                bias = in.rpb[(((size_t)l * B_HEADS + h) * (2 * NA_ROWS - 1) + (kr - row + NA_ROWS - 1)) * (2 * NA_COLS - 1) + (kc - col + NA_COLS - 1)] * LOG2E; }
            else krow = (size_t)NLAT + (size_t)b * CTX_LEN + (m - nnb);
            const bf16_t* kp = w.Z + krow * ZN + ZC_KB + h * HD; const bf16_t* vp = w.Z + krow * ZN + ZC_VB + h * HD;
            float s = bias; UNROLL for (int d = 0; d < HD; ++d) s += q[d] * bf2f(kp[d]);
            const float nm = s > mx ? s : mx, f = exp2f(mx - nm), p = exp2f(s - nm);
            lsum = lsum * f + p; UNROLL for (int d = 0; d < HD; ++d) o[d] = o[d] * f + p * bf2f(vp[d]); mx = nm;
        }
        UNROLL for (int d = 0; d < HD; ++d) w.OB[(size_t)r * BRANCH_W + h * HD + d] = f2bf(o[d] / lsum);
    }
}

GLOBAL_FN void p_gdn_naive(const KArgs& ka, const int l = 0, const int sh = 0, const int sc = 0) { const WS w = make_ws(ka.ws); (void)ka; (void)l; (void)sh; (void)sc;
    GSTRIDE_LOOP(i, (long)2 * BATCH * C_HEADS * HD) {
        const int j = (int)(i % HD); long t_ = i / HD; const int h = (int)(t_ % C_HEADS); t_ /= C_HEADS; const int b = (int)(t_ % BATCH), dir = (int)(t_ / BATCH);
        float S[HD]; UNROLL for (int k = 0; k < HD; ++k) S[k] = 0.f;
        for (int seg = 0; seg < 2; ++seg) {
            const int len = seg == 0 ? CTX_LEN : SEQ; const size_t base = seg == 0 ? (size_t)NLAT + (size_t)b * CTX_LEN : (size_t)b * SEQ;
            for (int s = 0; s < len; ++s) {
                const size_t r = base + (dir == 0 ? s : len - 1 - s);
                const bf16_t* kp = w.KC + r * C_W + h * HD; const bf16_t* qp = w.QC + r * C_W + h * HD;
                const float a = expf(w.G[(r * 2 + dir) * C_HEADS + h]), be = w.BETA[(r * 2 + dir) * C_HEADS + h], vj = bf2f(w.VC[r * C_W + h * HD + j]);
                float ks = 0.f; UNROLL for (int k = 0; k < HD; ++k) ks += bf2f(kp[k]) * S[k];
                const float dl = be * (vj - a * ks);
                float o = 0.f; UNROLL for (int k = 0; k < HD; ++k) { S[k] = a * S[k] + bf2f(kp[k]) * dl; o += bf2f(qp[k]) * S[k]; }
                w.OCD[((size_t)dir * NTOK + r) * C_W + h * HD + j] = o;
            }
        }
    }
}
GLOBAL_FN void p_gdn_fin(const KArgs& ka, const int l = 0, const int sh = 0, const int sc = 0) { const Inputs in = make_inputs(ka); const WS w = make_ws(ka.ws);  (void)ka; (void)l; (void)sh; (void)sc;
    GSTRIDE_LOOP(i, (long)NTOK * C_HEADS) {
        const int h = (int)(i % C_HEADS); const size_t r = (size_t)(i / C_HEADS);
        float o[HD]; float ss = 0.f;
        UNROLL for (int d = 0; d < HD; ++d) { o[d] = w.OCD[r * C_W + h * HD + d] + w.OCD[((size_t)NTOK + r) * C_W + h * HD + d]; ss += o[d] * o[d]; }
        const float rs = 1.0f / sqrtf(ss / HD + LN_EPS);
        UNROLL for (int d = 0; d < HD; ++d) w.OC[r * BRANCH_W + h * HD + d] = f2bf(o[d] * rs * in.o_gain[(size_t)l * HD + d] * siluf(bf2f(w.Z[r * ZN + ZC_GC + h * HD + d])));
    }
}

GLOBAL_FN void p_branch_naive(const KArgs& ka, const int l = 0, const int sh = 0, const int sc = 0) { const WS w = make_ws(ka.ws);  (void)ka; (void)l; (void)sh; (void)sc;
    GSTRIDE_LOOP(i, (long)NTOK * D_MODEL) { const int c = (int)(i % D_MODEL); const size_t r = (size_t)(i / D_MODEL); float m = 0.f;
        for (int br = 0; br < N_BRANCH; ++br) { const bf16_t* o = (br == 0 ? w.OA : br == 1 ? w.OB : w.OC) + r * BRANCH_W;
            m += bf2f(w.Z[r * ZN + ZC_MG + br * D_MODEL + c]) * dot_bf(o, w.WbrT + (((size_t)l * N_BRANCH + br) * D_MODEL + c) * BRANCH_W, BRANCH_W); }
        w.MB[i] = f2bf(m); }
}
constexpr float DEEPNORM_ALPHA_HOST = 0.f;
HD_FN float deepnorm_alpha() { return sqrtf(sqrtf(2.0f * DEPTH)); }
GLOBAL_FN void p_out_naive(const KArgs& ka, const int l = 0, const int sh = 0, const int sc = 0) { const WS w = make_ws(ka.ws);  (void)ka; (void)l; (void)sh; (void)sc;
    GSTRIDE_LOOP(i, (long)NTOK * D_MODEL) { const int c = (int)(i % D_MODEL); const int r = (int)(i / D_MODEL);
        const float mix = dot_bf(w.MB + (size_t)r * D_MODEL, w.WoutT + ((size_t)l * D_MODEL + c) * D_MODEL, D_MODEL);
        w.X[i] = deepnorm_alpha() * w.X[i] + modp(w, l, r, 2)[c] * mix; }
}
GLOBAL_FN void p_ln1_router(const KArgs& ka, const int l = 0, const int sh = 0, const int sc = 0) { const Inputs in = make_inputs(ka); const WS w = make_ws(ka.ws);  (void)ka; (void)l; (void)sh; (void)sc;
    GSTRIDE_LOOP(r, NTOK) {
        float* x = w.X + (size_t)r * D_MODEL; float mu = 0.f, var = 0.f;
        for (int c = 0; c < D_MODEL; ++c) mu += x[c];
        mu /= D_MODEL;
        for (int c = 0; c < D_MODEL; ++c) { const float d = x[c] - mu; var += d * d; }
        float rs = 1.0f / sqrtf(var / D_MODEL + LN_EPS);
        float mu2 = 0.f;
        for (int c = 0; c < D_MODEL; ++c) { x[c] = (x[c] - mu) * rs * in.ln1_g[(size_t)l * D_MODEL + c] + in.ln1_b[(size_t)l * D_MODEL + c]; mu2 += x[c]; }
        mu2 /= D_MODEL; var = 0.f;
        for (int c = 0; c < D_MODEL; ++c) { const float d = x[c] - mu2; var += d * d; }
        rs = 1.0f / sqrtf(var / D_MODEL + LN_EPS);
        const float *ms = modp(w, l, (int)r, 3), *mc = modp(w, l, (int)r, 4);
        float lg[N_EXPERTS]; UNROLL for (int e = 0; e < N_EXPERTS; ++e) lg[e] = 0.f;
        for (int c = 0; c < D_MODEL; ++c) { const float hv = (x[c] - mu2) * rs * (1.0f + mc[c]) + ms[c]; w.H[(size_t)r * D_MODEL + c] = f2bf(hv);
            UNROLL for (int e = 0; e < N_EXPERTS; ++e) lg[e] += hv * in.w_router[((size_t)l * D_MODEL + c) * N_EXPERTS + e]; }
        float mx = lg[0]; UNROLL for (int e = 1; e < N_EXPERTS; ++e) mx = lg[e] > mx ? lg[e] : mx;
        float sm = 0.f; UNROLL for (int e = 0; e < N_EXPERTS; ++e) { lg[e] = expf(lg[e] - mx); sm += lg[e]; }
        UNROLL for (int e = 0; e < N_EXPERTS; ++e) w.AFF[(size_t)r * N_EXPERTS + e] = lg[e] / sm;
    }
}
GLOBAL_FN void p_topk_naive(const KArgs& ka, const int l = 0, const int sh = 0, const int sc = 0) { const WS w = make_ws(ka.ws); (void)ka; (void)l; (void)sh; (void)sc;
    GSTRIDE_LOOP(i, (long)NTOK * N_EXPERTS) {
        const int e = (int)(i % N_EXPERTS); const int r = (int)(i / N_EXPERTS);
        const bool lat = r < NLAT; const int b = lat ? r / SEQ : (r - NLAT) / CTX_LEN, len = lat ? SEQ : CTX_LEN, cap = lat ? CAP_L : CAP_C;
        const int base = lat ? b * SEQ : NLAT + b * CTX_LEN; const float mine = w.AFF[(size_t)r * N_EXPERTS + e];
        int rank = 0;
        for (int t = 0; t < len; ++t) { const float o = w.AFF[(size_t)(base + t) * N_EXPERTS + e]; rank += (o > mine || (o == mine && base + t < r)) ? 1 : 0; }
        int slot = -1;
        if (rank < cap) { slot = lat ? (e * BATCH + b) * CAP_L + rank : NSLOT_L + (e * BATCH + b) * CAP_C + rank; w.TOKLIST[slot] = r; w.GATEV[slot] = mine; }
        w.SLOTOF[i] = slot;
    }
}
GLOBAL_FN void p_gather_xs(const KArgs& ka, const int l = 0, const int sh = 0, const int sc = 0) { const WS w = make_ws(ka.ws); (void)ka; (void)l; (void)sh; (void)sc;
    GSTRIDE_LOOP(i, (long)NSLOT * D_MODEL / 8) { const int c8 = (int)(i % (D_MODEL / 8)); const int s = (int)(i / (D_MODEL / 8));
        for (int j = 0; j < 8; ++j) w.XS[(size_t)s * D_MODEL + c8 * 8 + j] = w.H[(size_t)w.TOKLIST[s] * D_MODEL + c8 * 8 + j]; }
}
GLOBAL_FN void p_moe1_naive(const KArgs& ka, const int l = 0, const int sh = 0, const int sc = 0) { const WS w = make_ws(ka.ws);  (void)ka; (void)l; (void)sh; (void)sc;
    GSTRIDE_LOOP(i, (long)NSLOT * D_EXPERT) { const int c = (int)(i % D_EXPERT); const int s = (int)(i / D_EXPERT); const int e = slot_expert(s);
        const bf16_t* a = w.H + (size_t)w.TOKLIST[s] * D_MODEL; const bf16_t* wt = w.WguT + ((size_t)l * N_EXPERTS + e) * 2 * D_EXPERT * D_MODEL;
        const float g = dot_bf(a, wt + (size_t)gu_row(0, c) * D_MODEL, D_MODEL), u = dot_bf(a, wt + (size_t)gu_row(1, c) * D_MODEL, D_MODEL);
        w.ACT[i] = f2bf(siluf(g) * u); }
}
GLOBAL_FN void p_moe2_naive(const KArgs& ka, const int l = 0, const int sh = 0, const int sc = 0) { const WS w = make_ws(ka.ws);  (void)ka; (void)l; (void)sh; (void)sc;
    GSTRIDE_LOOP(i, (long)NSLOT * D_MODEL) { const int c = (int)(i % D_MODEL); const int s = (int)(i / D_MODEL); const int e = slot_expert(s);
        w.YS[i] = f2bf(w.GATEV[s] * dot_bf(w.ACT + (size_t)s * D_EXPERT, w.WdnT + (((size_t)l * N_EXPERTS + e) * D_MODEL + c) * D_EXPERT, D_EXPERT)); }
}
GLOBAL_FN void p_ln2(const KArgs& ka, const int l = 0, const int sh = 0, const int sc = 0) { const Inputs in = make_inputs(ka); const WS w = make_ws(ka.ws);  float* out = ka.out; (void)ka; (void)l; (void)sh; (void)sc;
    GSTRIDE_LOOP(r, NTOK) {
        float* x = w.X + (size_t)r * D_MODEL; const float* m5 = modp(w, l, (int)r, 5); float mu = 0.f, var = 0.f;
        for (int c = 0; c < D_MODEL; ++c) { float moe = 0.f;
            UNROLL for (int e = 0; e < N_EXPERTS; ++e) { const int s = w.SLOTOF[(size_t)r * N_EXPERTS + e]; if (s >= 0) moe += bf2f(w.YS[(size_t)s * D_MODEL + c]); }
            x[c] = deepnorm_alpha() * x[c] + m5[c] * moe; mu += x[c]; }
        mu /= D_MODEL;
        for (int c = 0; c < D_MODEL; ++c) { const float d = x[c] - mu; var += d * d; }
        float rs = 1.0f / sqrtf(var / D_MODEL + LN_EPS);
        float mu2 = 0.f;
        for (int c = 0; c < D_MODEL; ++c) { x[c] = (x[c] - mu) * rs * in.ln2_g[(size_t)l * D_MODEL + c] + in.ln2_b[(size_t)l * D_MODEL + c]; mu2 += x[c]; }
        if (l == DEPTH - 1) { if (r < NLAT) for (int c = 0; c < D_MODEL; ++c) out[(size_t)r * D_MODEL + c] = x[c]; continue; }
        mu2 /= D_MODEL; var = 0.f;
        for (int c = 0; c < D_MODEL; ++c) { const float d = x[c] - mu2; var += d * d; }
        rs = 1.0f / sqrtf(var / D_MODEL + LN_EPS);
        const float *ms = modp(w, l + 1, (int)r, 0), *mc = modp(w, l + 1, (int)r, 1);
        for (int c = 0; c < D_MODEL; ++c) w.H[(size_t)r * D_MODEL + c] = f2bf((x[c] - mu2) * rs * (1.0f + mc[c]) + ms[c]);
    }
}


#ifndef HOST_TEST
constexpr int KTID_TAB_OFF = 131072 + 512;
__device__ __forceinline__ int ktid() {
    extern __shared__ __attribute__((aligned(16))) unsigned char lds_all_[];
    const unsigned key = (unsigned)__builtin_amdgcn_s_getreg((5 << 11) | 4) & 63u;
    const int w = __builtin_amdgcn_readfirstlane(((const volatile __attribute__((address_space(3))) int*)((__attribute__((address_space(3))) unsigned char*)lds_all_ + KTID_TAB_OFF))[key]);
    int ln; asm volatile("v_mbcnt_lo_u32_b32 %0, -1, 0\n\tv_mbcnt_hi_u32_b32 %0, -1, %0" : "=v"(ln));
    return w * 64 + ln;
}
__device__ __forceinline__ float shf_idx(float v, int src) { return __int_as_float(__builtin_amdgcn_ds_bpermute(src << 2, __float_as_int(v))); }
__device__ __forceinline__ unsigned shu_idx(unsigned v, int src) { return (unsigned)__builtin_amdgcn_ds_bpermute(src << 2, (int)v); }
__device__ __forceinline__ int shi_idx(int v, int src) { return __builtin_amdgcn_ds_bpermute(src << 2, v); }
namespace pg8 {
#define PG8_LAS __attribute__((address_space(3)))
typedef short bf16x8 __attribute__((ext_vector_type(8)));
typedef float f32x4 __attribute__((ext_vector_type(4)));
typedef unsigned u32x4 __attribute__((ext_vector_type(4)));
typedef unsigned u32x2 __attribute__((ext_vector_type(2)));
constexpr int BM = 256, BK = 64, HALF = 128, HTB = HALF * BK * 2, STAGE_BYTES = 8 * HTB, NXCD = 8, WGM = 8, TOK_OFF = 8 * HTB + 2048, ROWV_OFF = 8 * HTB + 4096;
__host__ __device__ __forceinline__ int lds_byte(int r, int c) { const int st = (r >> 4) * 2 + (c >> 5), rr = r & 15, cc = c & 31, ob = rr * 64 + cc * 2; return st * 1024 + (ob ^ (((ob >> 9) & 1) << 5)); }
__host__ __device__ __forceinline__ void stage_rc(int b, int& R, int& C) { const int st = b / 1024, sb = b % 1024, swz = sb ^ (((sb >> 9) & 1) << 5); R = (st >> 1) * 16 + swz / 64; C = (st & 1) * 32 + (swz % 64) / 2; }
__host__ __device__ __forceinline__ int perm32(int rho) { const int n = rho >> 4, i = rho & 15; return 8 * (i >> 2) + 4 * n + (i & 3); }
struct Unit { int pm, pn, aux; };
typedef float f32x2_t __attribute__((ext_vector_type(2))); typedef __bf16 bf16x2_t __attribute__((ext_vector_type(2)));
__device__ __forceinline__ unsigned cvt_pk_bf16(float lo, float hi) { const f32x2_t v = {lo, hi}; return __builtin_bit_cast(unsigned, __builtin_convertvector(v, bf16x2_t)); }
__device__ __forceinline__ bool order_mn(int i, int G, int c, int nM, int nN, int& pm, int& pn) {
    const int nwg = nM * nN; const long L = (long)i * G + c; if (L >= nwg) return false;
    int wgid = (int)L; { const int q = nwg / NXCD, r = nwg % NXCD, xcd = wgid % NXCD, off = wgid / NXCD; wgid = (xcd < r ? xcd * (q + 1) : r * (q + 1) + (xcd - r) * q) + off; }
    const int nig = WGM * nN, gid = wgid / nig, fm = gid * WGM, gsz = (nM - fm) < WGM ? (nM - fm) : WGM;
    pm = fm + ((wgid % nig) % gsz); pn = (wgid % nig) / gsz; return true;
}
template <class Epi, class Sched, bool ALIGN_EPI = true, bool SP2 = true, bool GATHER = false>
__device__ __forceinline__ void gemm_phase(PG8_LAS unsigned char* lds, const int K, const Sched& S, const Epi& E) {
    int tid_ = ktid(); asm volatile("" : "+v"(tid_));
    const int tid = tid_, wid = __builtin_amdgcn_readfirstlane(tid >> 6), lane = tid & 63, wr = wid >> 2, wc = wid & 3, fr = lane & 15, fq = lane >> 4;
    const int nt = K / BK;
    static_assert(!GATHER || SP2, "the gathered A path is wired into the SP2 loop only");
    unsigned voffA[2], voffB[2]; int gR[2]; unsigned gC[2];
#pragma unroll
    for (int i = 0; i < 2; ++i) { int R, C; stage_rc(tid * 16 + i * 8192, R, C); const int Rb = Epi::PERM ? ((R & ~31) + perm32(R & 31)) : R;
        voffA[i] = (unsigned)(R * K + C) * 2u; voffB[i] = (unsigned)(Rb * K + C) * 2u; gR[i] = R; gC[i] = (unsigned)C * 2u; }
    unsigned cvA[2][2], nvA[2][2];
#define PG8_GFILL(dst, u) do { _Pragma("unroll") for (int _h = 0; _h < 2; ++_h) _Pragma("unroll") for (int _i = 0; _i < 2; ++_i) dst[_h][_i] = (unsigned)S.atok((u), _h * HALF + gR[_i]) * (unsigned)(K * 2) + gC[_i]; } while (0)
#define PG8_STAGE_A(bufoff, kp, h, nx) do { if constexpr (GATHER) { _Pragma("unroll") for (int _i = 0; _i < 2; ++_i) { const unsigned _o = (nx) ? nvA[h][_i] : cvA[h][_i]; \
        __builtin_amdgcn_global_load_lds((const unsigned*)((const char*)(kp) + _o), (PG8_LAS unsigned*)(lds + (bufoff) + ldsw + _i * 8192), 16, 0, 0); } } \
        else { PG8_STAGE(bufoff, (kp) + (h) * hstep, voffA); } } while (0)
    const size_t kstep = (size_t)(BK * 2);
    const size_t hstep = (size_t)HALF * K * 2;
    const unsigned ldsw = (unsigned)wid * 1024u;
    const int aoff = lds_byte(wr * 64 + fr, fq * 8), boff = lds_byte(wc * 32 + fr, fq * 8);
#define PG8_SA(b, h) (((b) * 2 + (h)) * HTB)
#define PG8_SB(b, h) ((4 + (b) * 2 + (h)) * HTB)
#define PG8_STAGE(bufoff, gbase, voff) do { _Pragma("unroll") for (int _i = 0; _i < 2; ++_i) \
        __builtin_amdgcn_global_load_lds((const unsigned*)((const char*)(gbase) + (voff)[_i]), (PG8_LAS unsigned*)(lds + (bufoff) + ldsw + _i * 8192), 16, 0, 0); } while (0)
#define PG8_LDA(dst, b, h) do { _Pragma("unroll") for (int m = 0; m < 4; ++m) _Pragma("unroll") for (int k = 0; k < 2; ++k) dst[m][k] = *(const PG8_LAS bf16x8*)(lds + PG8_SA(b, h) + aoff + m * 2048 + k * 1024); } while (0)
#define PG8_LDB(dst, b, h) do { _Pragma("unroll") for (int n = 0; n < 2; ++n) _Pragma("unroll") for (int k = 0; k < 2; ++k) dst[n][k] = *(const PG8_LAS bf16x8*)(lds + PG8_SB(b, h) + boff + n * 2048 + k * 1024); } while (0)
#define PG8_MMA(ai, bj, At, Bt) do { __builtin_amdgcn_s_setprio(1); _Pragma("unroll") for (int m = 0; m < 4; ++m) _Pragma("unroll") for (int n = 0; n < 2; ++n) _Pragma("unroll") for (int k = 0; k < 2; ++k) \
        acc[ai][bj][m][n] = __builtin_amdgcn_mfma_f32_16x16x32_bf16(Bt[n][k], At[m][k], acc[ai][bj][m][n], 0, 0, 0); __builtin_amdgcn_s_setprio(0); } while (0)
#define PG8_WAIT_V(n) asm volatile("s_waitcnt vmcnt(" #n ")" ::: "memory")
#define PG8_WAIT_L(n) asm volatile("s_waitcnt lgkmcnt(" #n ")" ::: "memory")
#define PG8_BAR __builtin_amdgcn_s_barrier()
#define PG8_SCHED __builtin_amdgcn_sched_barrier(0)
    Unit cur, nxt; int ui = 0;
    if (!S.next(0, cur)) return;
    f32x4 acc[2][2][4][2];
#pragma unroll
    for (int a = 0; a < 2; ++a)
#pragma unroll
        for (int b = 0; b < 2; ++b)
#pragma unroll
            for (int m = 0; m < 4; ++m)
#pragma unroll
                for (int n = 0; n < 2; ++n) acc[a][b][m][n] = (f32x4){0.f, 0.f, 0.f, 0.f};
    bf16x8 At[4][2], B0[2][2], B1[2][2];
    const char* cA = S.abase(cur); const char* cB = S.bbase(cur);
    if constexpr (GATHER) { PG8_GFILL(cvA, cur); }
    if constexpr (SP2) {
        PG8_STAGE(PG8_SB(0, 0), cB, voffB); PG8_STAGE(PG8_SB(0, 1), cB + hstep, voffB); PG8_STAGE_A(PG8_SA(0, 0), cA, 0, false); PG8_STAGE_A(PG8_SA(0, 1), cA, 1, false);
        if (wr == 1) PG8_BAR;
        PG8_WAIT_V(2); PG8_BAR;
        PG8_STAGE(PG8_SB(1, 0), cB + kstep, voffB); PG8_STAGE_A(PG8_SA(1, 0), cA + kstep, 0, false); PG8_STAGE(PG8_SB(1, 1), cB + hstep + kstep, voffB);
        PG8_WAIT_V(6); PG8_BAR;
    } else {
        PG8_STAGE(PG8_SB(0, 0), cB, voffB); PG8_STAGE(PG8_SA(0, 0), cA, voffA); PG8_STAGE(PG8_SB(0, 1), cB + hstep, voffB); PG8_STAGE(PG8_SA(0, 1), cA + hstep, voffA);
        if (wr == 1) PG8_BAR;
        PG8_WAIT_V(4); PG8_BAR;
        PG8_STAGE(PG8_SB(1, 0), cB + kstep, voffB); PG8_STAGE(PG8_SA(1, 0), cA + kstep, voffA); PG8_STAGE(PG8_SB(1, 1), cB + hstep + kstep, voffB);
        PG8_WAIT_V(6); PG8_BAR;
    }
    for (;;) {
        const bool has_next = S.next(ui + 1, nxt);
        const char* nA = has_next ? S.abase(nxt) : cA; const char* nB = has_next ? S.bbase(nxt) : cB;
        if constexpr (Epi::ROWV) { if (wid == 1) __builtin_amdgcn_global_load_lds((const unsigned*)(E.rowv(cur) + lane * 4), (PG8_LAS unsigned*)(lds + ROWV_OFF + (ui & 1) * 1024), 16, 0, 0); }
        if constexpr (GATHER) { if (has_next && wid == 0) __builtin_amdgcn_global_load_lds((const unsigned*)(S.toks(nxt) + lane * 4), (PG8_LAS unsigned*)(lds + TOK_OFF), 16, 0, 0); }
        for (int t = 0; t < nt; t += 2) {
            const bool last = (t == nt - 2);
            if constexpr (GATHER) { if (last) {
                if (has_next) { _Pragma("unroll") for (int _h = 0; _h < 2; ++_h) _Pragma("unroll") for (int _i = 0; _i < 2; ++_i) nvA[_h][_i] = ((const volatile PG8_LAS unsigned*)(lds + TOK_OFF))[_h * HALF + gR[_i]] * (unsigned)(K * 2) + gC[_i]; }
                else { _Pragma("unroll") for (int _h = 0; _h < 2; ++_h) _Pragma("unroll") for (int _i = 0; _i < 2; ++_i) nvA[_h][_i] = cvA[_h][_i]; } } }
            const char* a1 = cA + (size_t)(t + 1) * kstep;
            const char* a2 = last ? nA : cA + (size_t)(t + 2) * kstep; const char* b2 = last ? nB : cB + (size_t)(t + 2) * kstep;
            const char* a3 = a2 + kstep; const char* b3 = b2 + kstep;
            if constexpr (SP2) {
            PG8_LDB(B0, 0, 0); PG8_LDB(B1, 0, 1); PG8_SCHED; PG8_LDA(At, 0, 0); PG8_STAGE_A(PG8_SA(1, 1), a1, 1, false);
            PG8_WAIT_V(8); PG8_WAIT_L(0); PG8_BAR; PG8_MMA(0, 0, At, B0); PG8_MMA(0, 1, At, B1); PG8_BAR; PG8_SCHED;
            PG8_LDA(At, 0, 1); PG8_STAGE(PG8_SB(0, 0), b2, voffB); PG8_STAGE(PG8_SB(0, 1), b2 + hstep, voffB); PG8_STAGE_A(PG8_SA(0, 0), a2, 0, last);
            PG8_WAIT_V(8); PG8_WAIT_L(0); PG8_BAR; PG8_MMA(1, 0, At, B0); PG8_MMA(1, 1, At, B1); PG8_BAR; PG8_SCHED;
            PG8_LDB(B0, 1, 0); PG8_LDB(B1, 1, 1); PG8_SCHED; PG8_LDA(At, 1, 0); PG8_STAGE_A(PG8_SA(0, 1), a2, 1, last);
            PG8_WAIT_V(8); PG8_WAIT_L(0); PG8_BAR; PG8_MMA(0, 0, At, B0); PG8_MMA(0, 1, At, B1); PG8_BAR; PG8_SCHED;
            PG8_LDA(At, 1, 1); PG8_STAGE(PG8_SB(1, 0), b3, voffB); PG8_STAGE(PG8_SB(1, 1), b3 + hstep, voffB); PG8_STAGE_A(PG8_SA(1, 0), a3, 0, last);
            PG8_WAIT_V(8); PG8_WAIT_L(0); PG8_BAR; PG8_MMA(1, 0, At, B0); PG8_MMA(1, 1, At, B1); PG8_BAR; PG8_SCHED;
            } else {
            PG8_LDB(B0, 0, 0); PG8_SCHED; PG8_LDA(At, 0, 0); PG8_STAGE(PG8_SA(1, 1), a1 + hstep, voffA);
            PG8_WAIT_L(8); PG8_BAR; PG8_WAIT_L(0); PG8_MMA(0, 0, At, B0); PG8_BAR; PG8_SCHED;
            PG8_LDB(B1, 0, 1); PG8_STAGE(PG8_SB(0, 0), b2, voffB);
            PG8_BAR; PG8_WAIT_L(0); PG8_MMA(0, 1, At, B1); PG8_BAR;
            PG8_LDA(At, 0, 1); PG8_STAGE(PG8_SA(0, 0), a2, voffA);
            PG8_BAR; PG8_WAIT_L(0); PG8_MMA(1, 0, At, B0); PG8_BAR; PG8_SCHED;
            PG8_STAGE(PG8_SB(0, 1), b2 + hstep, voffB);
            PG8_WAIT_V(6); PG8_BAR; PG8_MMA(1, 1, At, B1); PG8_BAR;
            PG8_LDB(B0, 1, 0); PG8_SCHED; PG8_LDA(At, 1, 0); PG8_STAGE(PG8_SA(0, 1), a2 + hstep, voffA);
            PG8_WAIT_L(8); PG8_BAR; PG8_WAIT_L(0); PG8_MMA(0, 0, At, B0); PG8_BAR; PG8_SCHED;
            PG8_LDB(B1, 1, 1); PG8_STAGE(PG8_SB(1, 0), b3, voffB);
            PG8_BAR; PG8_WAIT_L(0); PG8_MMA(0, 1, At, B1); PG8_BAR;
            PG8_LDA(At, 1, 1); PG8_STAGE(PG8_SA(1, 0), a3, voffA);
            PG8_BAR; PG8_WAIT_L(0); PG8_MMA(1, 0, At, B0); PG8_BAR; PG8_SCHED;
            PG8_STAGE(PG8_SB(1, 1), b3 + hstep, voffB);
            PG8_WAIT_V(6); PG8_BAR; PG8_MMA(1, 1, At, B1); PG8_BAR;
            }
        }
        if constexpr (ALIGN_EPI) { if (wr == 0) PG8_BAR; }
        if constexpr (Epi::ROWV) E(acc, cur, wr, wc, fr, fq, (const PG8_LAS float*)(lds + ROWV_OFF + (ui & 1) * 1024)); else E(acc, cur, wr, wc, fr, fq);
        if (!has_next) break;
        bool keep_acc = false; if constexpr (Epi::CHAIN) keep_acc = E.keep(cur);
        if (!keep_acc) {
#pragma unroll
        for (int a = 0; a < 2; ++a)
#pragma unroll
            for (int b = 0; b < 2; ++b)
#pragma unroll
                for (int m = 0; m < 4; ++m)
#pragma unroll
                    for (int n = 0; n < 2; ++n) acc[a][b][m][n] = (f32x4){0.f, 0.f, 0.f, 0.f}; }
        cur = nxt; cA = nA; cB = nB; ++ui;
        if constexpr (GATHER) { _Pragma("unroll") for (int _h = 0; _h < 2; ++_h) _Pragma("unroll") for (int _i = 0; _i < 2; ++_i) cvA[_h][_i] = nvA[_h][_i]; }
        if constexpr (ALIGN_EPI) { if (wr == 1) PG8_BAR; }
    }
    PG8_WAIT_V(0);
    if constexpr (!ALIGN_EPI) { if (wr == 0) PG8_BAR; }
    PG8_BAR;
#undef PG8_SA
#undef PG8_SB
#undef PG8_STAGE
#undef PG8_STAGE_A
#undef PG8_GFILL
#undef PG8_LDA
#undef PG8_LDB
#undef PG8_MMA
#undef PG8_WAIT_V
#undef PG8_WAIT_L
#undef PG8_BAR
#undef PG8_SCHED
}
}

using pg8::f32x4; using pg8::u32x4; using pg8::u32x2; using pg8::Unit; using pg8::HALF; using pg8::BM;
__device__ __forceinline__ float fast_sigmoid(float x) { return __builtin_amdgcn_rcpf(1.0f + __builtin_amdgcn_exp2f(-x * LOG2E)); }
__device__ __forceinline__ f32x4 fast_sigmoid4(f32x4 x) { f32x4 e = x * (-LOG2E);
#pragma unroll
    for (int j = 0; j < 4; ++j) e[j] = __builtin_amdgcn_exp2f(e[j]);
    e = e + 1.0f;
#pragma unroll
    for (int j = 0; j < 4; ++j) e[j] = __builtin_amdgcn_rcpf(e[j]);
    return e; }
__device__ __forceinline__ float bflo(unsigned u) { return __uint_as_float(u << 16); }
__device__ __forceinline__ float bfhi(unsigned u) { return __uint_as_float(u & 0xffff0000u); }

struct SchedIn { __device__ __forceinline__ int atok(const Unit&, int) const { return 0; } const bf16_t* H; const bf16_t* WinT_l; int G, c;
    __device__ __forceinline__ bool next(int i, Unit& u) const { u.aux = 0; return pg8::order_mn(i, G, c, NTOK / BM, ZN / BM, u.pm, u.pn); }
    __device__ __forceinline__ const char* abase(const Unit& u) const { return (const char*)(H + (size_t)u.pm * BM * D_MODEL); }
    __device__ __forceinline__ const char* bbase(const Unit& u) const { return (const char*)(WinT_l + (size_t)u.pn * BM * D_MODEL); } };
struct SchedBranch { __device__ __forceinline__ int atok(const Unit&, int) const { return 0; } const bf16_t* OA; const bf16_t* WbrT_l; int G, c, nM;
    __device__ __forceinline__ bool next(int i, Unit& u) const { const int t = (i / N_BRANCH) * G + c; if (t >= nM * (D_MODEL / BM)) return false; u.aux = i % N_BRANCH; u.pm = t / (D_MODEL / BM); u.pn = t % (D_MODEL / BM); return true; }
    __device__ __forceinline__ const char* abase(const Unit& u) const { return (const char*)(OA + (size_t)u.aux * (WSO.OB - WSO.OA) / 2 + (size_t)u.pm * BM * BRANCH_W); }
    __device__ __forceinline__ const char* bbase(const Unit& u) const { return (const char*)(WbrT_l + ((size_t)u.aux * D_MODEL + (size_t)u.pn * BM) * BRANCH_W); } };
static_assert(WSO.OC - WSO.OB == WSO.OB - WSO.OA && WSO.OB - WSO.OA == (size_t)NTOK * BRANCH_W * 2 && 2 * BRANCH_W == D_MODEL, "branch outputs equally spaced and contiguous (OA|OB doubles as the [NTOK][D_MODEL] mix buffer)");
struct SchedOut { __device__ __forceinline__ int atok(const Unit&, int) const { return 0; } const bf16_t* MB; const bf16_t* WoutT_l; int G, c, nM;
    __device__ __forceinline__ bool next(int i, Unit& u) const { u.aux = 0; return pg8::order_mn(i, G, c, nM, D_MODEL / BM, u.pm, u.pn); }
    __device__ __forceinline__ const char* abase(const Unit& u) const { return (const char*)(MB + (size_t)u.pm * BM * D_MODEL); }
    __device__ __forceinline__ const char* bbase(const Unit& u) const { return (const char*)(WoutT_l + (size_t)u.pn * BM * D_MODEL); } };
struct SchedMoe1 { const bf16_t* H; const int* TOKLIST; const bf16_t* WguT_l; int G, c, nM;
    __device__ __forceinline__ bool next(int i, Unit& u) const { u.aux = 0; return pg8::order_mn(i, G, c, nM, 2 * D_EXPERT / BM, u.pm, u.pn); }
    __device__ __forceinline__ int atok(const Unit& u, int r) const { return TOKLIST[u.pm * BM + r]; }
    __device__ __forceinline__ const int* toks(const Unit& u) const { return TOKLIST + u.pm * BM; }
    __device__ __forceinline__ const char* abase(const Unit&) const { return (const char*)H; }
    __device__ __forceinline__ const char* bbase(const Unit& u) const { return (const char*)(WguT_l + ((size_t)slot_expert(u.pm * BM) * 2 * D_EXPERT + (size_t)u.pn * BM) * D_MODEL); } };
struct SchedMoe2 { __device__ __forceinline__ int atok(const Unit&, int) const { return 0; } const bf16_t* ACT; const bf16_t* WdnT_l; int G, c, nM;
    __device__ __forceinline__ bool next(int i, Unit& u) const { u.aux = 0; return pg8::order_mn(i, G, c, nM, D_MODEL / BM, u.pm, u.pn); }
    __device__ __forceinline__ const char* abase(const Unit& u) const { return (const char*)(ACT + (size_t)u.pm * BM * D_EXPERT); }
    __device__ __forceinline__ const char* bbase(const Unit& u) const { return (const char*)(WdnT_l + ((size_t)slot_expert(u.pm * BM) * D_MODEL + (size_t)u.pn * BM) * D_EXPERT); } };
static_assert(ZC_QB % BM == 0 && B_W % BM == 0 && ZC_KB % BM == 0 && ZC_VB % BM == 0 && ZC_VB == ZC_KB + B_W && HD == 64 && 2 * KVB_BYTES <= (size_t)NSLOT * D_MODEL * 2 && SEQ % BM == 0 && CTX_LEN % BM == 0, "mixer-B query / key / value columns are whole units; compact K / V fit the XS region");
static_assert(CAP_L % BM == 0 && (BATCH * CAP_C) % BM == 0 && NTOK % BM == 0 && ZN % BM == 0 && NSLOT % BM == 0, "unit shapes");

struct EpiZ { static constexpr bool ROWV = false; static constexpr bool CHAIN = false; static constexpr bool PERM = true; bf16_t* Z; bf16_t* GT; bf16_t* KVB;
    __device__ __forceinline__ void operator()(const f32x4 (&acc)[2][2][4][2], const Unit& u, int wr, int wc, int fr, int fq) const {
        const int row0 = u.pm * BM + wr * 64 + fr, col0 = u.pn * BM + wc * 32 + 8 * fq;
        const float sc = (u.pn * BM >= ZC_QB && u.pn * BM < ZC_QB + B_W) ? QSCALE : 1.0f;
        const bool gate = u.pn * BM >= ZC_MG;
        const int gcol = u.pn * BM - ZC_MG; bf16_t* gtp = GT + ((size_t)(((size_t)u.pm * (D_MODEL / BM) + (gcol % D_MODEL) / BM) * N_BRANCH + gcol / D_MODEL) * 16 * 512 + ((wr * 4 + wc) * 64 + fq * 16 + fr)) * 8;
        if (gate) {
#pragma unroll
            for (int ai = 0; ai < 2; ++ai)
#pragma unroll
                for (int m = 0; m < 4; ++m)
#pragma unroll
                    for (int bj = 0; bj < 2; ++bj) { const f32x4 v0 = fast_sigmoid4(acc[ai][bj][m][0]), v1 = fast_sigmoid4(acc[ai][bj][m][1]);
                        u32x4 o; o.x = pg8::cvt_pk_bf16(v0[0], v0[1]); o.y = pg8::cvt_pk_bf16(v0[2], v0[3]); o.z = pg8::cvt_pk_bf16(v1[0], v1[1]); o.w = pg8::cvt_pk_bf16(v1[2], v1[3]);
                        __builtin_nontemporal_store(o, (u32x4*)(gtp + (size_t)(((ai * 4 + m) * 2 + bj) * 512) * 8)); }
        } else if (u.pn * BM >= ZC_KB && u.pn * BM < ZC_VB + B_W) {
            const int isv = u.pn * BM >= ZC_VB ? 1 : 0, cu = u.pn * BM - (isv ? ZC_VB : ZC_KB), ur = u.pm * BM;
            const int bb = ur < NLAT ? ur / SEQ : (ur - NLAT) / CTX_LEN, t0 = ur < NLAT ? ur % SEQ : SEQ + (ur - NLAT) % CTX_LEN;
            bf16_t* kb = KVB + (size_t)isv * (KVB_BYTES / 2) + (size_t)(wc & 1) * 32 + 8 * fq;
#pragma unroll
            for (int ai = 0; ai < 2; ++ai)
#pragma unroll
                for (int m = 0; m < 4; ++m) { const int tl = t0 + wr * 64 + fr + ai * HALF + m * 16;
#pragma unroll
                    for (int bj = 0; bj < 2; ++bj) { const f32x4 v0 = acc[ai][bj][m][0], v1 = acc[ai][bj][m][1]; const int head = cu / HD + bj * 2 + (wc >> 1);
                        u32x4 o; o.x = pg8::cvt_pk_bf16(v0[0], v0[1]); o.y = pg8::cvt_pk_bf16(v0[2], v0[3]); o.z = pg8::cvt_pk_bf16(v1[0], v1[1]); o.w = pg8::cvt_pk_bf16(v1[2], v1[3]);
                        *(u32x4*)(kb + ((size_t)(bb * B_HEADS + head) * KVLEN + tl) * HD) = o; } }
        } else {
#pragma unroll
            for (int ai = 0; ai < 2; ++ai)
#pragma unroll
                for (int m = 0; m < 4; ++m) { bf16_t* rowp = Z + (size_t)(row0 + ai * HALF + m * 16) * ZN + col0;
#pragma unroll
                    for (int bj = 0; bj < 2; ++bj) { const f32x4 v0 = acc[ai][bj][m][0] * sc, v1 = acc[ai][bj][m][1] * sc;
                        u32x4 o; o.x = pg8::cvt_pk_bf16(v0[0], v0[1]); o.y = pg8::cvt_pk_bf16(v0[2], v0[3]); o.z = pg8::cvt_pk_bf16(v1[0], v1[1]); o.w = pg8::cvt_pk_bf16(v1[2], v1[3]);
                        __builtin_nontemporal_store(o, (u32x4*)(rowp + bj * HALF)); } }
        }
    } };
#define GB_N 8
#if GB_N == 8
#define GB_FENCE(a) asm volatile("" : "+v"(a[0]), "+v"(a[1]), "+v"(a[2]), "+v"(a[3]), "+v"(a[4]), "+v"(a[5]), "+v"(a[6]), "+v"(a[7]))
#else
#define GB_FENCE(a) asm volatile("" : "+v"(a[0]), "+v"(a[1]), "+v"(a[2]), "+v"(a[3]))
#endif
struct EpiBranch { static constexpr bool ROWV = false; static constexpr bool CHAIN = true; static constexpr bool PERM = true; const bf16_t* GT; bf16_t* MB;
    __device__ __forceinline__ bool keep(const Unit& u) const { return u.aux < N_BRANCH - 1; }
    __device__ __forceinline__ void operator()(f32x4 (&acc)[2][2][4][2], const Unit& u, int wr, int wc, int fr, int fq) const {
        const int row0 = u.pm * BM + wr * 64 + fr, col0 = u.pn * BM + wc * 32 + 8 * fq; const int br = u.aux; const bool lastb = br == N_BRANCH - 1;
        const bf16_t* gt0 = GT + ((size_t)(((size_t)u.pm * (D_MODEL / BM) + u.pn) * N_BRANCH + br) * 16 * 512 + ((wr * 4 + wc) * 64 + fq * 16 + fr)) * 8;
        u32x4 gb[GB_N], gnb[GB_N];
#pragma unroll
        for (int ai = 0; ai < 2; ++ai) {
#pragma unroll
            for (int m = 0; m < 4; ++m) { const size_t row = (size_t)(row0 + ai * HALF + m * 16);
#pragma unroll
                for (int bj = 0; bj < 2; ++bj) { const int col = col0 + bj * HALF;
                    if ((m * 2 + bj) % GB_N == 0 && !(lastb && ai == 1)) {
#pragma unroll
                        for (int q = 0; q < GB_N; ++q) { const bf16_t* gp = gt0 + (size_t)((ai * 8 + m * 2 + bj + q) * 512) * 8; gb[q] = *(const u32x4*)gp; gnb[q] = *(const u32x4*)(gp + (size_t)(lastb ? 8 : 16) * 512 * 8); }
                        GB_FENCE(gb); GB_FENCE(gnb); }
                    if (lastb && ai == 1 && m * 2 + bj == 0) {
#pragma unroll
                        for (int q = 0; q < GB_N; ++q) gb[q] = gnb[q]; }
                    const u32x4 g = gb[(m * 2 + bj) % GB_N]; const u32x4 gn = lastb ? g : gnb[(m * 2 + bj) % GB_N];
                    float f[8];
#pragma unroll
                    for (int e = 0; e < 4; ++e) { const float a0 = bflo(g[e]), a1 = bfhi(g[e]);
                        f[2 * e] = lastb ? a0 : a0 * __builtin_amdgcn_rcpf(fmaxf(bflo(gn[e]), 1e-30f)); f[2 * e + 1] = lastb ? a1 : a1 * __builtin_amdgcn_rcpf(fmaxf(bfhi(gn[e]), 1e-30f)); }
                    f32x4& a0v = acc[ai][bj][m][0]; f32x4& a1v = acc[ai][bj][m][1];
                    a0v[0] *= f[0]; a0v[1] *= f[1]; a0v[2] *= f[2]; a0v[3] *= f[3]; a1v[0] *= f[4]; a1v[1] *= f[5]; a1v[2] *= f[6]; a1v[3] *= f[7];
                    if (lastb) { u32x4 o; o.x = pg8::cvt_pk_bf16(a0v[0], a0v[1]); o.y = pg8::cvt_pk_bf16(a0v[2], a0v[3]); o.z = pg8::cvt_pk_bf16(a1v[0], a1v[1]); o.w = pg8::cvt_pk_bf16(a1v[2], a1v[3]);
                        *(u32x4*)(MB + row * D_MODEL + col) = o; } } } }
    } };
struct EpiOut { static constexpr bool ROWV = false; static constexpr bool CHAIN = false; static constexpr bool PERM = true; bf16_t* MIX;
    __device__ __forceinline__ void operator()(const f32x4 (&acc)[2][2][4][2], const Unit& u, int wr, int wc, int fr, int fq) const {
        const int row0 = u.pm * BM + wr * 64 + fr, col0 = u.pn * BM + wc * 32 + 8 * fq;
#pragma unroll
        for (int ai = 0; ai < 2; ++ai)
#pragma unroll
            for (int m = 0; m < 4; ++m) { bf16_t* rowp = MIX + (size_t)(row0 + ai * HALF + m * 16) * D_MODEL + col0;
#pragma unroll
                for (int bj = 0; bj < 2; ++bj) { const f32x4 v0 = acc[ai][bj][m][0], v1 = acc[ai][bj][m][1];
                    u32x4 o; o.x = pg8::cvt_pk_bf16(v0[0], v0[1]); o.y = pg8::cvt_pk_bf16(v0[2], v0[3]); o.z = pg8::cvt_pk_bf16(v1[0], v1[1]); o.w = pg8::cvt_pk_bf16(v1[2], v1[3]);
                    *(u32x4*)(rowp + bj * HALF) = o; } }
    } };
static_assert(SEQ % BM == 0 && CTX_LEN % BM == 0, "modulation set per unit");
struct EpiGU { static constexpr bool ROWV = false; static constexpr bool CHAIN = false; static constexpr bool PERM = true; bf16_t* ACT;
    __device__ __forceinline__ void operator()(const f32x4 (&acc)[2][2][4][2], const Unit& u, int wr, int wc, int fr, int fq) const {
        const int row0 = u.pm * BM + wr * 64 + fr, col0 = u.pn * HALF + wc * 32 + 8 * fq;
#pragma unroll
        for (int ai = 0; ai < 2; ++ai)
#pragma unroll
            for (int m = 0; m < 4; ++m) { const f32x4 r0 = acc[ai][0][m][0] * acc[ai][1][m][0] * fast_sigmoid4(acc[ai][0][m][0]), r1 = acc[ai][0][m][1] * acc[ai][1][m][1] * fast_sigmoid4(acc[ai][0][m][1]);
                u32x4 o; o.x = pg8::cvt_pk_bf16(r0[0], r0[1]); o.y = pg8::cvt_pk_bf16(r0[2], r0[3]); o.z = pg8::cvt_pk_bf16(r1[0], r1[1]); o.w = pg8::cvt_pk_bf16(r1[2], r1[3]);
                __builtin_nontemporal_store(o, (u32x4*)(ACT + (size_t)(row0 + ai * HALF + m * 16) * D_EXPERT + col0)); }
    } };
static_assert(GU_BLK == HALF, "gate/up interleave matches the unit's two column halves");
struct EpiDown { static constexpr bool ROWV = true; static constexpr bool CHAIN = false; static constexpr bool PERM = true; const float* GATEV; bf16_t* YS;
    __device__ __forceinline__ const float* rowv(const Unit& u) const { return GATEV + (size_t)u.pm * BM; }
    __device__ __forceinline__ void operator()(const f32x4 (&acc)[2][2][4][2], const Unit& u, int wr, int wc, int fr, int fq, const PG8_LAS float* gl) const {
        const int row0 = u.pm * BM + wr * 64 + fr, col0 = u.pn * BM + wc * 32 + 8 * fq;
        float gv[2][4];
#pragma unroll
        for (int ai = 0; ai < 2; ++ai)
#pragma unroll
            for (int m = 0; m < 4; ++m) gv[ai][m] = gl[wr * 64 + fr + ai * HALF + m * 16];
#pragma unroll
        for (int ai = 0; ai < 2; ++ai)
#pragma unroll
            for (int m = 0; m < 4; ++m) { const int row = row0 + ai * HALF + m * 16; const float gt = gv[ai][m]; bf16_t* rowp = YS + (size_t)row * D_MODEL + col0;
#pragma unroll
                for (int bj = 0; bj < 2; ++bj) { const f32x4 v0 = acc[ai][bj][m][0] * gt, v1 = acc[ai][bj][m][1] * gt;
                    u32x4 o; o.x = pg8::cvt_pk_bf16(v0[0], v0[1]); o.y = pg8::cvt_pk_bf16(v0[2], v0[3]); o.z = pg8::cvt_pk_bf16(v1[0], v1[1]); o.w = pg8::cvt_pk_bf16(v1[2], v1[3]);
                    *(u32x4*)(rowp + bj * HALF) = o; } }
    } };

#include <hip/hip_bf16.h>
namespace attn_body {
using bf16=__hip_bfloat16;
using bf16x8=__attribute__((ext_vector_type(8)))short;
using s16x4=__attribute__((ext_vector_type(4)))short;
using f32x16=__attribute__((ext_vector_type(16)))float;
using u32x4=__attribute__((ext_vector_type(4)))unsigned;
constexpr int D=64;
constexpr int NW=8,QBLK=32,QB=QBLK*NW,KVBLK=64;
constexpr int ATTN_UNIT_ROWS=QB;
__device__ __forceinline__ int crow(int r,int hi){return (r&3)+8*(r>>2)+4*hi;}
#define SBAR() __builtin_amdgcn_sched_barrier(0)
__device__ __forceinline__ void cmask(f32x16&p0,f32x16&p1,int jb,int qrel,int hi){
  const float NEG=-INFINITY; int kb=64*jb+4*hi;
  #pragma unroll
  for(int r=0;r<16;++r){int kv=kb+(r&3)+8*(r>>2); if(kv>qrel)p0[r]=NEG; if(kv+32>qrel)p1[r]=NEG;}
}

constexpr int NSLOT=3, SLOTB=8192;
constexpr int LDS_K=0, LDS_V=NSLOT*SLOTB, LDS_WS=2*NSLOT*SLOTB, LDS_OST=LDS_WS+NW*64*4, LDS_BYTES=LDS_OST+NW*4096;
constexpr float C2=0.125f*1.4426950408889634f;
__device__ __forceinline__ void glds16(const void*gsrc,unsigned lds_dst){unsigned keep;
  asm volatile("s_mov_b32 %0, m0\n\ts_mov_b32 m0, %2\n\ts_nop 0\n\tglobal_load_lds_dwordx4 %1, off\n\ts_mov_b32 m0, %0":"=&s"(keep):"v"(gsrc),"s"(lds_dst):"memory");}
__device__ __forceinline__ float max3f(float a,float b,float c){float r;asm("v_max3_f32 %0, %1, %2, %3":"=v"(r):"v"(a),"v"(b),"v"(c));return r;}
__device__ __forceinline__ float max2f(float a,float b){float r;asm("v_max_f32_e32 %0, %1, %2":"=v"(r):"v"(a),"v"(b));return r;}
__device__ __forceinline__ float fadd_s(float a,float b){float r;asm("v_add_f32_e32 %0, %1, %2":"=v"(r):"v"(a),"v"(b));return r;}
__device__ __forceinline__ float fsub_s(float a,float b){float r;asm("v_sub_f32_e32 %0, %1, %2":"=v"(r):"v"(a),"v"(b));return r;}
typedef float f32x2_t __attribute__((ext_vector_type(2))); typedef __bf16 bf16x2_t __attribute__((ext_vector_type(2)));
__device__ __forceinline__ unsigned cvtpk_s(float lo,float hi){f32x2_t v={lo,hi};bf16x2_t b=__builtin_convertvector(v,bf16x2_t);return __builtin_bit_cast(unsigned,b);}
#define WAIT_BAR(N) asm volatile("s_waitcnt vmcnt(" #N ") lgkmcnt(0)\n\ts_barrier":::"memory")

__device__ __forceinline__ void qkt(f32x16&p0,f32x16&p1,const char*Kslot,const bf16x8*qr,const f32x16&negm,int r32,int hi){
  const char*kb=Kslot+hi*1024+r32*16;
  #pragma unroll
  for(int d0=0;d0<4;++d0){
    const bf16x8 b0=*reinterpret_cast<const bf16x8*>(kb+d0*2048);
    const bf16x8 b1=*reinterpret_cast<const bf16x8*>(kb+d0*2048+512);
    if(d0==0){p0=__builtin_amdgcn_mfma_f32_32x32x16_bf16(b0,qr[0],negm,0,0,0);p1=__builtin_amdgcn_mfma_f32_32x32x16_bf16(b1,qr[0],negm,0,0,0);}
    else{p0=__builtin_amdgcn_mfma_f32_32x32x16_bf16(b0,qr[d0],p0,0,0,0);p1=__builtin_amdgcn_mfma_f32_32x32x16_bf16(b1,qr[d0],p1,0,0,0);}}
}
typedef __attribute__((address_space(3))) const char* lds_cptr;
typedef short v4i16_t __attribute__((ext_vector_type(4)));
__device__ __forceinline__ void kload8(bf16x8*kf,lds_cptr kp){
  kf[0]=*(const __attribute__((address_space(3))) bf16x8*)(kp);      kf[1]=*(const __attribute__((address_space(3))) bf16x8*)(kp+512);
  kf[2]=*(const __attribute__((address_space(3))) bf16x8*)(kp+2048); kf[3]=*(const __attribute__((address_space(3))) bf16x8*)(kp+2560);
  kf[4]=*(const __attribute__((address_space(3))) bf16x8*)(kp+4096); kf[5]=*(const __attribute__((address_space(3))) bf16x8*)(kp+4608);
  kf[6]=*(const __attribute__((address_space(3))) bf16x8*)(kp+6144); kf[7]=*(const __attribute__((address_space(3))) bf16x8*)(kp+6656);
}
__device__ __forceinline__ void kload2(bf16x8*kf,lds_cptr kp,int j){ kf[2*j]=*(const __attribute__((address_space(3))) bf16x8*)(kp+j*2048); kf[2*j+1]=*(const __attribute__((address_space(3))) bf16x8*)(kp+j*2048+512); }
__device__ __forceinline__ s16x4 vtr(lds_cptr p){ return __builtin_bit_cast(s16x4,__builtin_amdgcn_ds_read_tr16_b64_v4i16((__attribute__((address_space(3))) v4i16_t*)p)); }
__device__ __forceinline__ float rowmax(const f32x16&p0,const f32x16&p1){
  float a=max3f(p0[0],p0[1],p1[0]),b=max3f(p0[2],p0[3],p1[1]);a=max3f(a,p1[2],p1[3]);
  #pragma unroll
  for(int r=4;r<16;r+=4){a=max3f(a,p0[r],p0[r+1]);b=max3f(b,p0[r+2],p0[r+3]);a=max3f(a,p1[r],p1[r+1]);b=max3f(b,p1[r+2],p1[r+3]);}
  const float m=max2f(a,b);
  auto rr=__builtin_amdgcn_permlane32_swap(__float_as_uint(m),__float_as_uint(m),false,false);
  return max2f(__uint_as_float(rr[0]),__uint_as_float(rr[1]));
}
__device__ __forceinline__ void pv(f32x16*o,int vb,bf16x8 pa0,bf16x8 pa1,bf16x8 pa2,bf16x8 pa3){
  #pragma unroll
  for(int d0=0;d0<2;++d0){s16x4 lo[4],hi[4];
    #pragma unroll
    for(int ks=0;ks<4;++ks){
      asm volatile("ds_read_b64_tr_b16 %0,%1 offset:%c2":"=&v"(lo[ks]):"v"(vb),"i"(d0*4096+ks*1024):"memory");
      asm volatile("ds_read_b64_tr_b16 %0,%1 offset:%c2":"=&v"(hi[ks]):"v"(vb),"i"(d0*4096+ks*1024+512):"memory");}
    asm volatile("s_waitcnt lgkmcnt(0)":::"memory");SBAR();
    #define PK(k) (bf16x8){lo[k][0],lo[k][1],lo[k][2],lo[k][3],hi[k][0],hi[k][1],hi[k][2],hi[k][3]}
    o[d0]=__builtin_amdgcn_mfma_f32_32x32x16_bf16(pa0,PK(0),o[d0],0,0,0);
    o[d0]=__builtin_amdgcn_mfma_f32_32x32x16_bf16(pa1,PK(1),o[d0],0,0,0);
    o[d0]=__builtin_amdgcn_mfma_f32_32x32x16_bf16(pa2,PK(2),o[d0],0,0,0);
    o[d0]=__builtin_amdgcn_mfma_f32_32x32x16_bf16(pa3,PK(3),o[d0],0,0,0);
    #undef PK
  }
}

#ifndef ATTN_STORE16
#define ATTN_STORE16(p,v) (*(u32x4*)(p)=(v))
#endif
template<int THRL,class TF,bool NEGM=true> __device__ __forceinline__ void attn_unit(const bf16*Qb,int QP,const bf16*__restrict__ Kh,const bf16*__restrict__ Vh,int KP,bf16*Ob,int OP,int NT,const TF&F,char*shm){
  int tid_=ktid(); asm volatile("":"+v"(tid_));
  const int tid=tid_,lane=tid&63,r32=lane&31,hi=lane>>5; const int wid=__builtin_amdgcn_readfirstlane(tid>>6);
  const bf16*Qw=Qb+(long)(wid*QBLK)*QP;
  const unsigned lds0=(unsigned)(uintptr_t)shm;
  float*wsf=(float*)(shm+LDS_WS)+wid*64;
  const bf16*ksrc=Kh+(long)lane*KP+wid*8;
  const bf16*vsrc=Vh+(long)(16*(wid&3)+(lane>>2))*KP+(wid>>2)*32+(lane&3)*8;
  const unsigned kdst=lds0+LDS_K+wid*1024, vdst=lds0+LDS_V+wid*1024;
  #define DMA_K(t,slot) glds16(ksrc+F.koff(t),(unsigned)__builtin_amdgcn_readfirstlane(kdst+(slot)))
  #define DMA_V(t,slot) glds16(vsrc+F.koff(t),(unsigned)__builtin_amdgcn_readfirstlane(vdst+(slot)))
  const int vb0=(int)(lds0+LDS_V)+((lane>>4)&1)*32+(lane&3)*8+(4*hi+((lane&15)>>2))*64;
  const char*Kbase=shm+LDS_K; bf16x8 kf[8];
  const lds_cptr shm3=(lds_cptr)shm; const lds_cptr kp0=shm3+LDS_K+hi*1024+r32*16; const lds_cptr vp0=shm3+LDS_V+((lane>>4)&1)*32+(lane&3)*8+(4*hi+((lane&15)>>2))*64;
  DMA_K(0,0);DMA_V(0,0);DMA_K(1,SLOTB);
  bf16x8 qr[4];
  #pragma unroll
  for(int d0=0;d0<4;++d0)qr[d0]=*reinterpret_cast<const bf16x8*>(&Qw[(long)r32*QP+d0*16+hi*8]);
  float mhat=0.f,l_reg=0.f;f32x16 o[2];o[0]=f32x16{};o[1]=f32x16{};f32x16 negm=f32x16{};if constexpr(NEGM)asm volatile("":"+v"(negm));
  const int qrel=wid*QBLK+r32;
  #define CMASK(P0,P1,t) F.mask(P0,P1,(t),qrel,hi)
  bool resc=false;
  #define START(P0,P1) do{ const float rm=rowmax(P0,P1); resc=false; \
    { const float dl=rm; mhat=fadd_s(mhat,dl); \
      _Pragma("unroll") for(int r=0;r<16;++r){P0[r]=fsub_s(P0[r],dl);P1[r]=fsub_s(P1[r],dl);} \
      if constexpr(NEGM){ _Pragma("unroll") for(int r=0;r<16;++r)negm[r]=-mhat; asm volatile("":"+v"(negm)); } } \
    _Pragma("unroll") for(int r=0;r<16;++r)P0[r]=__builtin_amdgcn_exp2f(P0[r]); }while(0)
  #define RESC() do{ if(resc){ asm volatile("s_waitcnt lgkmcnt(0)":::"memory"); \
      _Pragma("unroll") for(int d_=0;d_<2;++d_) _Pragma("unroll") for(int r=0;r<16;++r)o[d_][r]*=wsf[crow(r,hi)]; } }while(0)
  f32x16 pA0,pA1,pB0,pB1;
  int sl_prev=0,sl_cur=0,sl_next=SLOTB;
  #define ROT() do{sl_prev=sl_cur;sl_cur=sl_next;sl_next=(sl_next==(NSLOT-1)*SLOTB)?0:sl_next+SLOTB;}while(0)
  DMA_K(2,2*SLOTB);
  WAIT_BAR(3);
  qkt(pA0,pA1,Kbase,qr,negm,r32,hi);asm volatile("s_nop 15\n\ts_nop 7":"+v"(pA0),"+v"(pA1));CMASK(pA0,pA1,0);
  START(pA0,pA1);
  _Pragma("unroll") for(int r=0;r<16;++r)pA1[r]=__builtin_amdgcn_exp2f(pA1[r]);
  WAIT_BAR(0);
  DMA_K(3,0);DMA_V(1,SLOTB);
  ROT();
  kload8(kf,kp0+sl_cur);
  WAIT_BAR(2);
  s16x4 vlo[8],vhi[8]; u32x4 pw0,pw1,pw2,pw3;
  #define PKW(P,B) cvtpk_s(P[B],P[B+1])
  #define PAF(k) __builtin_bit_cast(bf16x8,pw##k)
  #define VFR(i) (bf16x8){vlo[i][0],vlo[i][1],vlo[i][2],vlo[i][3],vhi[i][0],vhi[i][1],vhi[i][2],vhi[i][3]}
  #define PIN(x) asm volatile("":"+v"(x))
  #define MX3(a,b,c) __builtin_fmaxf(__builtin_fmaxf((a),(b)),(c))
  #define GAPA(MF,A0,A1,A2,A3,W0,W1,PW) do{ MF; sacc+=A0; sacc+=A1; sacc+=A2; sacc+=A3; PIN(sacc); W0; W1; PIN(PW); SBAR(); }while(0)
  #define EX(v) __builtin_amdgcn_exp2f(v)
  #define GAPB(MF,X,B) do{ MF; X[B]=EX(X[B]); X[B+1]=EX(X[B+1]); X[B+2]=EX(X[B+2]); X[B+3]=EX(X[B+3]); PIN(X); SBAR(); }while(0)
  #define VRD(i) do{ vlo[i]=vtr(vp_+(((i)>>2)*4096+((i)&3)*1024)); vhi[i]=vtr(vp_+(((i)>>2)*4096+((i)&3)*1024+512)); }while(0)
  #define KRD(G,j) do{ if(G){ kload2(kf,kp0+sl_next,j); SBAR(); } }while(0)
  #define STEP(C0,C1,P0,P1,t,GK,GV,GL) do{ SBAR(); \
    const lds_cptr vp_=vp0+sl_prev; \
    VRD(0); SBAR(); float sacc=(P0[0]+P0[1]); \
    GAPA(C0=__builtin_amdgcn_mfma_f32_32x32x16_bf16(kf[0],qr[0],(NEGM?negm:f32x16{}),0,0,0), P0[2],P0[3],P0[4],P0[5],     pw0[0]=PKW(P0,0), pw0[1]=PKW(P0,2), pw0); \
    VRD(4); SBAR(); GAPA(C1=__builtin_amdgcn_mfma_f32_32x32x16_bf16(kf[1],qr[0],(NEGM?negm:f32x16{}),0,0,0), P0[6],P0[7],P0[8],P0[9],     pw0[2]=PKW(P0,4), pw0[3]=PKW(P0,6), pw0); \
    VRD(1); SBAR(); GAPA(C0=__builtin_amdgcn_mfma_f32_32x32x16_bf16(kf[2],qr[1],C0,0,0,0),   P0[10],P0[11],P0[12],P0[13], pw1[0]=PKW(P0,8), pw1[1]=PKW(P0,10), pw1); \
    VRD(5); SBAR(); GAPA(C1=__builtin_amdgcn_mfma_f32_32x32x16_bf16(kf[3],qr[1],C1,0,0,0),   P0[14],P0[15],P1[0],P1[1],   pw1[2]=PKW(P0,12),pw1[3]=PKW(P0,14), pw1); \
    VRD(2); SBAR(); GAPA(C0=__builtin_amdgcn_mfma_f32_32x32x16_bf16(kf[4],qr[2],C0,0,0,0),   P1[2],P1[3],P1[4],P1[5],     pw2[0]=PKW(P1,0), pw2[1]=PKW(P1,2), pw2); \
    VRD(6); SBAR(); GAPA(C1=__builtin_amdgcn_mfma_f32_32x32x16_bf16(kf[5],qr[2],C1,0,0,0),   P1[6],P1[7],P1[8],P1[9],     pw2[2]=PKW(P1,4), pw2[3]=PKW(P1,6), pw2); \
    VRD(3); SBAR(); GAPA(C0=__builtin_amdgcn_mfma_f32_32x32x16_bf16(kf[6],qr[3],C0,0,0,0),   P1[10],P1[11],P1[12],P1[13], pw3[0]=PKW(P1,8), pw3[1]=PKW(P1,10), pw3); \
    VRD(7); SBAR(); GAPA(C1=__builtin_amdgcn_mfma_f32_32x32x16_bf16(kf[7],qr[3],C1,0,0,0),   P1[14],P1[15],0.f,0.f,       pw3[2]=PKW(P1,12),pw3[3]=PKW(P1,14), pw3); \
    l_reg+=sacc; \
    if(GK){DMA_K((t)+3,sl_cur);} if(GV){DMA_V((t)+1,sl_next);} \
    if constexpr(!NEGM){ _Pragma("unroll") for(int r=0;r<16;++r){C0[r]-=mhat;C1[r]-=mhat;} } \
    CMASK(C0,C1,t); \
    { float a=MX3(C0[0],C0[1],C1[0]),b=MX3(C0[2],C0[3],C1[1]); a=MX3(a,C1[2],C1[3]); \
      _Pragma("unroll") for(int r=4;r<16;r+=4){a=MX3(a,C0[r],C0[r+1]);b=MX3(b,C0[r+2],C0[r+3]);a=MX3(a,C1[r],C1[r+1]);b=MX3(b,C1[r+2],C1[r+3]);} \
      float rm=__builtin_fmaxf(a,b); { auto rr=__builtin_amdgcn_permlane32_swap(__float_as_uint(rm),__float_as_uint(rm),false,false); rm=__builtin_fmaxf(__uint_as_float(rr[0]),__uint_as_float(rr[1])); } \
      resc=false; \
      if(__builtin_expect(__any(rm>(float)THRL),0)){ const float dl=__builtin_fmaxf(rm,0.f); mhat+=dl; \
        _Pragma("unroll") for(int r=0;r<16;++r){C0[r]-=dl;C1[r]-=dl;} \
        if constexpr(NEGM){ _Pragma("unroll") for(int r=0;r<16;++r)negm[r]=-mhat; asm volatile("":"+v"(negm)); } \
        const float f=__builtin_amdgcn_exp2f(-dl); l_reg*=f; if(hi==0)wsf[r32]=f; resc=true; } } \
    SBAR(); \
    GAPB(o[0]=__builtin_amdgcn_mfma_f32_32x32x16_bf16(PAF(0),VFR(0),o[0],0,0,0), C0,0); \
    GAPB(o[1]=__builtin_amdgcn_mfma_f32_32x32x16_bf16(PAF(0),VFR(4),o[1],0,0,0), C0,4); \
    KRD(GL,0); GAPB(o[0]=__builtin_amdgcn_mfma_f32_32x32x16_bf16(PAF(1),VFR(1),o[0],0,0,0), C0,8); \
    KRD(GL,1); GAPB(o[1]=__builtin_amdgcn_mfma_f32_32x32x16_bf16(PAF(1),VFR(5),o[1],0,0,0), C0,12); \
    KRD(GL,2); GAPB(o[0]=__builtin_amdgcn_mfma_f32_32x32x16_bf16(PAF(2),VFR(2),o[0],0,0,0), C1,0); \
    KRD(GL,3); GAPB(o[1]=__builtin_amdgcn_mfma_f32_32x32x16_bf16(PAF(2),VFR(6),o[1],0,0,0), C1,4); \
    GAPB(o[0]=__builtin_amdgcn_mfma_f32_32x32x16_bf16(PAF(3),VFR(3),o[0],0,0,0), C1,8); \
    GAPB(o[1]=__builtin_amdgcn_mfma_f32_32x32x16_bf16(PAF(3),VFR(7),o[1],0,0,0), C1,12); \
    }while(0)
  int t=1;
  for(;t+5<NT;t+=2){
    STEP(pB0,pB1,pA0,pA1,t,true,true,true);     WAIT_BAR(2); RESC(); ROT();
    STEP(pA0,pA1,pB0,pB1,t+1,true,true,true);   WAIT_BAR(2); RESC(); ROT();
  }
  #undef CMASK
  #define CMASK(P0,P1,t) F.mask(P0,P1,(t),qrel,hi)
  #define ENDW(tt) do{ if((tt)+3<NT){WAIT_BAR(2);} else if((tt)+2<NT){WAIT_BAR(1);} else {WAIT_BAR(0);} }while(0)
  for(;t+1<NT;t+=2){
    STEP(pB0,pB1,pA0,pA1,t,(t+3<NT),(t+1<NT),(t+1<NT));       ENDW(t);   RESC(); ROT();
    STEP(pA0,pA1,pB0,pB1,t+1,(t+4<NT),(t+2<NT),(t+2<NT));     ENDW(t+1); RESC(); ROT();
  }
  STEP(pB0,pB1,pA0,pA1,NT-1,false,false,false); RESC();
  { float sacc=pB0[0]+pB0[1]; _Pragma("unroll") for(int r=2;r<16;++r)sacc+=pB0[r]; _Pragma("unroll") for(int r=0;r<16;++r)sacc+=pB1[r]; l_reg+=sacc;
    pw0=(u32x4){PKW(pB0,0),PKW(pB0,2),PKW(pB0,4),PKW(pB0,6)};pw1=(u32x4){PKW(pB0,8),PKW(pB0,10),PKW(pB0,12),PKW(pB0,14)};pw2=(u32x4){PKW(pB1,0),PKW(pB1,2),PKW(pB1,4),PKW(pB1,6)};pw3=(u32x4){PKW(pB1,8),PKW(pB1,10),PKW(pB1,12),PKW(pB1,14)};
    SBAR(); pv(o,vb0+sl_cur,PAF(0),PAF(1),PAF(2),PAF(3)); }
  #undef PKW
  #undef PAF
  #undef VFR
  #undef PIN
  #undef MX3
  #undef GAPA
  #undef GAPB
  #undef EX
  #undef VRD
  #undef KRD
  #undef STEP
  #undef ENDW
  {auto rr=__builtin_amdgcn_permlane32_swap(__float_as_uint(l_reg),__float_as_uint(l_reg),false,false);l_reg=__uint_as_float(rr[0])+__uint_as_float(rr[1]);}
  if(hi==0)wsf[32+r32]=l_reg;asm volatile("s_waitcnt lgkmcnt(0)":::"memory");
  float rli[16];
  #pragma unroll
  for(int r=0;r<16;++r)rli[r]=__builtin_amdgcn_rcpf(wsf[32+crow(r,hi)]);
  bf16*Ow=Ob+(long)(wid*QBLK)*OP;
  { bf16*stg=(bf16*)(shm+LDS_OST)+wid*2048;
    #pragma unroll
    for(int r=0;r<16;++r){const int orow=crow(r,hi);
      #pragma unroll
      for(int d0=0;d0<2;++d0)stg[orow*64+d0*32+r32]=__float2bfloat16(o[d0][r]*rli[r]);}
    asm volatile("s_waitcnt lgkmcnt(0)":::"memory");
    #pragma unroll
    for(int i=0;i<4;++i){const int row=i*8+(lane>>3),ch=lane&7; const u32x4 v=*(const u32x4*)(stg+row*64+ch*8); ATTN_STORE16(Ow+(long)row*OP+ch*8,v);} }
  asm volatile("s_waitcnt lgkmcnt(0)\n\ts_barrier":::"memory");
  #undef DMA_K
  #undef DMA_V
  #undef CMASK
  #undef START
  #undef RESC
  #undef ROT
}
constexpr int ATTN_LDS_BYTES=LDS_BYTES;
#undef SBAR
#undef WAIT_BAR
}
struct DenseTF { long kstep; __device__ __forceinline__ long koff(int t) const { return (long)t * kstep; }
    __device__ __forceinline__ void mask(attn_body::f32x16&, attn_body::f32x16&, int, int, int) const {} };
constexpr int ATT_NBIG = BATCH * A_HEADS * (SEQ / 256), ATT_NSMALL = 2 * BATCH * A_HEADS;
static_assert(KVLEN % 128 == 0 && CTX_LEN == 256 && HD == 64 && A_HEADS == B_HEADS, "attention unit geometry");
__device__ __forceinline__ int claim_unit(unsigned* ctr, char* lds) {
    volatile __attribute__((address_space(3))) unsigned* w = (volatile __attribute__((address_space(3))) unsigned*)((__attribute__((address_space(3))) char*)lds + 131072 + 128);
    if (ktid() == 0) w[0] = __hip_atomic_fetch_add(ctr, 1u, __ATOMIC_RELAXED, __HIP_MEMORY_SCOPE_AGENT);
    __syncthreads(); const unsigned u = w[0]; __syncthreads();
    return (int)u;
}
__device__ __forceinline__ void attn_phase_dense(unsigned char* wsb, unsigned* ctr, int nunits, char* lds, int G, int c) {
    using attn_body::bf16;
    const bf16* KBc = (const bf16*)(ws_at(wsb, WSO.XS)); const bf16* VBc = (const bf16*)(ws_at(wsb, WSO.XS + KVB_BYTES));
    bf16* QA = (bf16*)(ws_at(wsb, WSO.QA)); bf16* KA = (bf16*)(ws_at(wsb, WSO.KA)); bf16* VA = (bf16*)(ws_at(wsb, WSO.VA)); bf16* OA = (bf16*)(ws_at(wsb, WSO.OA)); bf16* OB = (bf16*)(ws_at(wsb, WSO.OB)); bf16* Z = (bf16*)(ws_at(wsb, WSO.Z));
    for (;;) { const int uu = claim_unit(ctr, lds); if (uu >= nunits) break;
        const bf16 *Qb, *Kh, *Vh; bf16* Ob; int QP, KP, NT;
        if (uu < ATT_NBIG) { const int u = uu;
            const int qb = u % (SEQ / 256), h = (u / (SEQ / 256)) % A_HEADS, b = u / (SEQ / 256 * A_HEADS), kvh = h / (A_HEADS / A_KV_HEADS);
            const size_t qrow = (size_t)b * SEQ + (size_t)qb * 256;
            Qb = QA + qrow * A_Q_W + h * HD; Ob = OA + qrow * BRANCH_W + h * HD; QP = A_Q_W;
            Kh = KA + (size_t)(b * A_KV_HEADS + kvh) * KVLEN * HD; Vh = VA + (size_t)(b * A_KV_HEADS + kvh) * KVLEN * HD; KP = HD; NT = KVLEN / 64;
        } else { const int u = uu - ATT_NBIG;
            const int h = u % A_HEADS, b = (u / A_HEADS) % BATCH, kind = u / (A_HEADS * BATCH); const size_t qrow = (size_t)NLAT + (size_t)b * CTX_LEN; NT = CTX_LEN / 64;
            if (kind == 0) { const int kvh = h / (A_HEADS / A_KV_HEADS); Qb = QA + qrow * A_Q_W + h * HD; Ob = OA + qrow * BRANCH_W + h * HD; QP = A_Q_W;
                Kh = KA + ((size_t)(b * A_KV_HEADS + kvh) * KVLEN + SEQ) * HD; Vh = VA + ((size_t)(b * A_KV_HEADS + kvh) * KVLEN + SEQ) * HD; KP = HD; }
            else { Qb = Z + qrow * ZN + ZC_QB + h * HD; Ob = OB + qrow * BRANCH_W + h * HD; QP = ZN; Kh = KBc + ((size_t)(b * B_HEADS + h) * KVLEN + SEQ) * HD; Vh = VBc + ((size_t)(b * B_HEADS + h) * KVLEN + SEQ) * HD; KP = HD; }
        }
        const DenseTF F{(long)64 * KP};
        attn_body::attn_unit<8>(Qb, QP, Kh, Vh, KP, Ob, BRANCH_W, NT, F, lds);
    }
}


constexpr int NA_TAB_OFF = 86016, NA_TAB_N = (2 * NA_ROWS - 1) * (2 * NA_COLS - 1);
static_assert(NA_TAB_OFF >= attn_body::ATTN_LDS_BYTES && NA_TAB_OFF + 4096 <= 131072 && GRID_W == 64 && NA_ROWS == 8 && NA_COLS == 16 && GRID_H >= 16, "neighbourhood geometry");
struct NaTF { long ctx_off0, lat_off0; int kr_lo, nwin, r0; const __attribute__((address_space(3))) float* tab;
    __device__ __forceinline__ long koff(int t) const { const int w_ = t - 4; return t < 4 ? ctx_off0 + (long)t * 64 * HD : lat_off0 + (long)(w_ < nwin ? w_ : nwin - 1) * 64 * HD; }
    __device__ __forceinline__ void mask(attn_body::f32x16& p0, attn_body::f32x16& p1, int t, int qrel, int hi) const {
        if (t < 4) return;
        const int kr = kr_lo + (t - 4), qr = r0 + (qrel >> 6), qc = qrel & 63;
        const int rs = min(max(qr - NA_ROWS / 2, 0), GRID_H - NA_ROWS), cs = min(max(qc - NA_COLS / 2, 0), GRID_W - NA_COLS);
        const bool rowok = (unsigned)(kr - rs) < (unsigned)NA_ROWS;
        const int ri = min(max(kr - qr + NA_ROWS - 1, 0), 2 * NA_ROWS - 2);
        const __attribute__((address_space(3))) float* tb = tab + ri * (2 * NA_COLS - 1) + (4 * hi - qc + NA_COLS - 1);
        const int off = rowok ? 4 * hi - cs : 0x40000000;
#pragma unroll
        for (int r = 0; r < 16; ++r) { const int kc0 = (r & 3) + 8 * (r >> 2);
            p0[r] = (unsigned)(kc0 + off) < (unsigned)NA_COLS ? p0[r] + tb[kc0] : -INFINITY;
            p1[r] = (unsigned)(kc0 + 32 + off) < (unsigned)NA_COLS ? p1[r] + tb[kc0 + 32] : -INFINITY; }
    } };
constexpr int NA_UNITS = BATCH * B_HEADS * (GRID_H / 4);
__device__ __forceinline__ void attn_phase_na(unsigned char* wsb, const float* rpb_l, unsigned* ctr, char* lds, int G, int c) {
    using attn_body::bf16;
    bf16* Z = (bf16*)(ws_at(wsb, WSO.Z)); bf16* OB = (bf16*)(ws_at(wsb, WSO.OB)); const bf16* KBc = (const bf16*)(ws_at(wsb, WSO.XS)); const bf16* VBc = (const bf16*)(ws_at(wsb, WSO.XS + KVB_BYTES));
    __attribute__((address_space(3))) float* tab = (__attribute__((address_space(3))) float*)((__attribute__((address_space(3))) char*)lds + NA_TAB_OFF);
    for (;;) { const int u = claim_unit(ctr, lds); if (u >= NA_UNITS) break;
        const int rb = u % (GRID_H / 4), h = (u / (GRID_H / 4)) % B_HEADS, b = u / (GRID_H / 4 * B_HEADS), r0 = rb * 4;
        const int kr_lo = min(max(r0 - NA_ROWS / 2, 0), GRID_H - NA_ROWS), kr_hi = min(max(r0 + 3 - NA_ROWS / 2, 0), GRID_H - NA_ROWS) + NA_ROWS - 1, nwin = kr_hi - kr_lo + 1;
        int tid_ = ktid(); asm volatile("" : "+v"(tid_));
        for (int i = tid_; i < NA_TAB_N; i += 512) tab[i] = rpb_l[(size_t)h * NA_TAB_N + i] * LOG2E;
        const size_t qrow = (size_t)b * SEQ + (size_t)r0 * GRID_W;
        const NaTF F{(long)SEQ * HD, (long)kr_lo * GRID_W * HD, kr_lo, nwin, r0, tab};
        const size_t kvb = (size_t)(b * B_HEADS + h) * KVLEN * HD;
        attn_body::attn_unit<8, NaTF, false>(Z + qrow * ZN + ZC_QB + h * HD, ZN, KBc + kvb, VBc + kvb, HD, OB + qrow * BRANCH_W + h * HD, BRANCH_W, (4 + nwin + 1) & ~1, F, lds);
    }
}

namespace gdn {
#define GLAS __attribute__((address_space(3)))
typedef short bf16x8 __attribute__((ext_vector_type(8)));
typedef float f32x16 __attribute__((ext_vector_type(16)));
typedef float f32x4 __attribute__((ext_vector_type(4)));
typedef unsigned u32x4 __attribute__((ext_vector_type(4)));
typedef unsigned u32x2 __attribute__((ext_vector_type(2)));
constexpr int NCH = KVLEN / 64, NCHAIN = 2 * BATCH * C_HEADS, FRAGS = 41, CHUNK_BYTES = FRAGS * 1024, NCTXCH = CTX_LEN / 64;
static_assert(HD == 64 && CTX_LEN % 64 == 0 && SEQ % 64 == 0 && 3 * CHUNK_BYTES <= 131072 && NCH >= 2, "chunk geometry");
typedef float f32x2_t __attribute__((ext_vector_type(2))); typedef __bf16 bf16x2_t __attribute__((ext_vector_type(2)));
__device__ __forceinline__ unsigned pk(float lo, float hi) { const f32x2_t v = {lo, hi}; return __builtin_bit_cast(unsigned, __builtin_convertvector(v, bf16x2_t)); }
__device__ __forceinline__ float blo(unsigned u) { return __uint_as_float(u << 16); }
__device__ __forceinline__ float bhi(unsigned u) { return __uint_as_float(u & 0xffff0000u); }
__device__ __forceinline__ int smat(int i, int j) { return i * 128 + ((((j >> 3) ^ i) & 7) << 4) + ((j & 7) << 1); }
__device__ __forceinline__ int chunk_row(int dir, int b, int ci, int p) {
    const bool cx = ci < NCTXCH; const int len = cx ? CTX_LEN : SEQ, cl = cx ? ci : ci - NCTXCH, base = cx ? NLAT + b * CTX_LEN : b * SEQ, t = cl * 64 + p;
    return base + (dir ? len - 1 - t : t);
}
__device__ __forceinline__ bf16x8 asfrag(u32x4 v) { return __builtin_bit_cast(bf16x8, v); }
#define GDN_FENCE() asm volatile("" ::: "memory")

__device__ __forceinline__ void intra_unit(unsigned char* wsb, int chain, int ci, GLAS unsigned char* L, int lane0) {
    const int h = chain % C_HEADS, b = (chain / C_HEADS) % BATCH, dir = chain / (C_HEADS * BATCH);
    const bf16_t* QC = (const bf16_t*)(ws_at(wsb, WSO.QC)) + h * HD; const bf16_t* KC = (const bf16_t*)(ws_at(wsb, WSO.KC)) + h * HD; const bf16_t* VC = (const bf16_t*)(ws_at(wsb, WSO.VC)) + h * HD;
    unsigned char* gop = ws_at(wsb, WSO.GOP) + ((size_t)chain * NCH + ci) * CHUNK_BYTES;
    GLAS unsigned char* R1 = L + 8192;
#define GDN_STAGE int ln_ = lane0; asm volatile("" : "+v"(ln_)); const int lane = ln_, m31 = ln_ & 31, hh = ln_ >> 5; (void)lane; (void)m31; (void)hh; \
    const size_t myrow = (size_t)chunk_row(dir, b, ci, lane); (void)myrow; \
    const size_t frow[2] = {(size_t)chunk_row(dir, b, ci, m31) * C_W + 8 * hh, (size_t)chunk_row(dir, b, ci, 32 + m31) * C_W + 8 * hh}; (void)frow; \
    int tb[8]; _Pragma("unroll") for (int x = 0; x < 8; ++x) tb[x] = x * 128 + ((((lane >> 3) ^ x) & 7) << 4) + ((lane & 7) << 1); (void)tb;
#define GDN_TRANSPOSE_IN(X, sc) do { _Pragma("unroll") for (int y = 0; y < 8; ++y) { const u32x4 v = *(const u32x4*)((X) + myrow * C_W + 8 * y); \
        _Pragma("unroll") for (int e = 0; e < 4; ++e) { const unsigned wv = v[e]; const unsigned two = pk(blo(wv) * (sc), bhi(wv) * (sc)); \
            *(GLAS unsigned short*)(R1 + tb[2 * e] + 1024 * y) = (unsigned short)(two & 0xffffu); *(GLAS unsigned short*)(R1 + tb[2 * e + 1] + 1024 * y) = (unsigned short)(two >> 16); } } } while (0)
#define GDN_AFRAG(mat, row, ks) ({ const u32x2 p0_ = *(const GLAS u32x2*)((mat) + smat((row), 16 * (ks) + 4 * hh)), p1_ = *(const GLAS u32x2*)((mat) + smat((row), 16 * (ks) + 8 + 4 * hh)); (u32x4){p0_.x, p0_.y, p1_.x, p1_.y}; })
#define GDN_EMIT(fbase, mat) do { _Pragma("unroll") for (int a = 0; a < 2; ++a) _Pragma("unroll") for (int ks = 0; ks < 4; ++ks) \
        __builtin_nontemporal_store(GDN_AFRAG(mat, 32 * a + m31, ks), (u32x4*)(gop + (size_t)((fbase) + a * 4 + ks) * 1024 + lane * 16)); } while (0)
    float gc, be, eg, ek;
    f32x16 Lr[3];
    { GDN_STAGE
      be = ((const float*)(ws_at(wsb, WSO.BETA)))[(myrow * 2 + dir) * C_HEADS + h];
      gc = ((const float*)(ws_at(wsb, WSO.G)))[(myrow * 2 + dir) * C_HEADS + h];
#pragma unroll
      for (int o = 1; o < 64; o <<= 1) { const float t = shf_idx(gc, lane - o); if (lane >= o) gc += t; }
      const float glast = shf_idx(gc, 63); eg = __expf(gc); ek = __expf(glast - gc);
      *(float*)(gop + 40 * 1024 + lane * 16) = __expf(glast);
      bf16x8 kf[2][4];
#pragma unroll
      for (int t = 0; t < 2; ++t)
#pragma unroll
        for (int s = 0; s < 4; ++s) kf[t][s] = *(const bf16x8*)(KC + frow[t] + 16 * s);
#pragma unroll
      for (int tt = 0; tt < 3; ++tt) { const int ti = tt == 0 ? 0 : 1, tj = tt == 2 ? 1 : 0;
        f32x16 acc = {};
#pragma unroll
        for (int s = 0; s < 4; ++s) acc = __builtin_amdgcn_mfma_f32_32x32x16_bf16(kf[ti][s], kf[tj][s], acc, 0, 0, 0);
        const int j = 32 * tj + m31; const float gj = shf_idx(gc, j);
#pragma unroll
        for (int g4 = 0; g4 < 4; ++g4)
#pragma unroll
            for (int e = 0; e < 4; ++e) { const int i = 32 * ti + e + 8 * g4 + 4 * hh; const float gi = shf_idx(gc, i), bi = shf_idx(be, i); Lr[tt][4 * g4 + e] = i > j ? bi * acc[4 * g4 + e] * __expf(gi - gj) : 0.f; }
      }
    }
    GDN_FENCE();
    { GDN_STAGE
      float T[64];
#pragma unroll
      for (int j = 0; j < 64; ++j) T[j] = 0.f;
      T[63] = lane == 63 ? 1.f : 0.f;
#pragma unroll
      for (int j = 62; j >= 0; --j) { float a0 = 0.f, a1 = 0.f, a2 = 0.f, a3 = 0.f;
#pragma unroll
        for (int i = j + 1; i < 64; ++i) { const float lij = __int_as_float(__builtin_amdgcn_readlane(__float_as_int(Lr[(i >> 5) + (j >> 5)][(i & 3) + 4 * ((i & 31) >> 3)]), (j & 31) + 32 * (((i & 31) >> 2) & 1)));
            if ((i & 3) == 0) a0 += T[i] * lij; else if ((i & 3) == 1) a1 += T[i] * lij; else if ((i & 3) == 2) a2 += T[i] * lij; else a3 += T[i] * lij; }
        int lj_ = lane; asm volatile("" : "+v"(lj_)); T[j] = (lj_ == j ? 1.f : 0.f) - ((a0 + a1) + (a2 + a3)); }
      GDN_FENCE();
#pragma unroll
      for (int ch = 0; ch < 8; ++ch) { u32x4 o; o.x = pk(T[8 * ch], T[8 * ch + 1]); o.y = pk(T[8 * ch + 2], T[8 * ch + 3]); o.z = pk(T[8 * ch + 4], T[8 * ch + 5]); o.w = pk(T[8 * ch + 6], T[8 * ch + 7]);
        *(GLAS u32x4*)(L + smat(lane, 8 * ch)) = o; }
    }
    GDN_FENCE();
    { GDN_STAGE const float sc = be * eg; GDN_TRANSPOSE_IN(KC, sc); }
    GDN_FENCE();
    { GDN_STAGE
      bf16x8 af[2][4], bfr[2][4];
#pragma unroll
      for (int a = 0; a < 2; ++a)
#pragma unroll
        for (int s = 0; s < 4; ++s) { af[a][s] = *(const GLAS bf16x8*)(R1 + smat(32 * a + m31, 16 * s + 8 * hh)); bfr[a][s] = *(const GLAS bf16x8*)(L + smat(32 * a + m31, 16 * s + 8 * hh)); }
      f32x16 acc[2][2];
#pragma unroll
      for (int a = 0; a < 2; ++a)
#pragma unroll
        for (int bb = 0; bb < 2; ++bb) { acc[a][bb] = (f32x16){};
#pragma unroll
            for (int s = 0; s < 4; ++s) acc[a][bb] = __builtin_amdgcn_mfma_f32_32x32x16_bf16(af[a][s], bfr[bb][s], acc[a][bb], 0, 0, 0); }
      GDN_FENCE();
#pragma unroll
      for (int a = 0; a < 2; ++a)
#pragma unroll
        for (int bb = 0; bb < 2; ++bb)
#pragma unroll
            for (int g4 = 0; g4 < 4; ++g4) { u32x2 o; o.x = pk(-acc[a][bb][4 * g4], -acc[a][bb][4 * g4 + 1]); o.y = pk(-acc[a][bb][4 * g4 + 2], -acc[a][bb][4 * g4 + 3]);
                *(GLAS u32x2*)(R1 + smat(32 * bb + m31, 32 * a + 8 * g4 + 4 * hh)) = o; }
      GDN_FENCE();
      GDN_EMIT(0, R1);
    }
    GDN_FENCE();
    { GDN_STAGE GDN_TRANSPOSE_IN(VC, be); }
    GDN_FENCE();
    { GDN_STAGE
      bf16x8 af[2][4], bfr[2][4];
#pragma unroll
      for (int a = 0; a < 2; ++a)
#pragma unroll
        for (int s = 0; s < 4; ++s) { af[a][s] = *(const GLAS bf16x8*)(L + smat(32 * a + m31, 16 * s + 8 * hh)); bfr[a][s] = *(const GLAS bf16x8*)(R1 + smat(32 * a + m31, 16 * s + 8 * hh)); }
#pragma unroll
      for (int bb = 0; bb < 2; ++bb)
#pragma unroll
        for (int a = 0; a < 2; ++a) { f32x16 acc = {};
#pragma unroll
            for (int s = 0; s < 4; ++s) acc = __builtin_amdgcn_mfma_f32_32x32x16_bf16(af[a][s], bfr[bb][s], acc, 0, 0, 0);
#pragma unroll
            for (int part = 0; part < 2; ++part) { u32x4 o; o.x = pk(acc[8 * part], acc[8 * part + 1]); o.y = pk(acc[8 * part + 2], acc[8 * part + 3]); o.z = pk(acc[8 * part + 4], acc[8 * part + 5]); o.w = pk(acc[8 * part + 6], acc[8 * part + 7]);
                __builtin_nontemporal_store(o, (u32x4*)(gop + (size_t)(32 + (bb * 2 + a) * 2 + part) * 1024 + lane * 16)); } }
    }
    GDN_FENCE();
    { GDN_STAGE
#pragma unroll
      for (int ch = 0; ch < 8; ++ch) { const u32x4 v = *(const u32x4*)(QC + myrow * C_W + 8 * ch); u32x4 o;
#pragma unroll
        for (int e = 0; e < 4; ++e) o[e] = pk(blo(v[e]) * eg, bhi(v[e]) * eg);
        *(GLAS u32x4*)(L + smat(lane, 8 * ch)) = o; }
      GDN_TRANSPOSE_IN(KC, ek);
      GDN_FENCE();
      GDN_EMIT(8, L); GDN_EMIT(24, R1);
    }
    GDN_FENCE();
    { GDN_STAGE
      bf16x8 qf[2][4], kf[2][4];
#pragma unroll
      for (int t = 0; t < 2; ++t)
#pragma unroll
        for (int s = 0; s < 4; ++s) { qf[t][s] = *(const bf16x8*)(QC + frow[t] + 16 * s); kf[t][s] = *(const bf16x8*)(KC + frow[t] + 16 * s); }
#pragma unroll
      for (int tj = 0; tj < 2; ++tj)
#pragma unroll
        for (int ti = 0; ti < 2; ++ti) { f32x16 acc = {};
            if (ti >= tj) {
#pragma unroll
                for (int s = 0; s < 4; ++s) acc = __builtin_amdgcn_mfma_f32_32x32x16_bf16(kf[tj][s], qf[ti][s], acc, 0, 0, 0); }
            const int i = 32 * ti + m31; const float gi = shf_idx(gc, i);
#pragma unroll
            for (int g4 = 0; g4 < 4; ++g4) { float v[4];
#pragma unroll
                for (int e = 0; e < 4; ++e) { const int j = 32 * tj + e + 8 * g4 + 4 * hh; const float gj = shf_idx(gc, j); v[e] = i >= j ? acc[4 * g4 + e] * __expf(gi - gj) : 0.f; }
                u32x2 o; o.x = pk(v[0], v[1]); o.y = pk(v[2], v[3]); *(GLAS u32x2*)(L + smat(i, 32 * tj + 8 * g4 + 4 * hh)) = o; } }
      GDN_FENCE();
      GDN_EMIT(16, L);
    }
    GDN_FENCE();
#undef GDN_STAGE
#undef GDN_TRANSPOSE_IN
#undef GDN_AFRAG
#undef GDN_EMIT
}
__device__ __forceinline__ void intra_phase(unsigned char* wsb, char* lds, int G, int c) {
    int tid_ = ktid(); asm volatile("" : "+v"(tid_));
    const int lane = tid_ & 63, wid = __builtin_amdgcn_readfirstlane(tid_ >> 6);
    GLAS unsigned char* L = (GLAS unsigned char*)lds + wid * 16384;
    const int U = NCHAIN * NCH, W = G * 8, full = U / W * W, remw = (U - full + G - 1) / G;
    for (int u = c * 8 + wid; u < full; u += W) intra_unit(wsb, u / NCH, u % NCH, L, lane);
    if (wid < remw) { const int u = full + wid * G + c; if (u < U) intra_unit(wsb, u / NCH, u % NCH, L, lane); }
}

__device__ __forceinline__ void scan_chain(unsigned char* wsb, int chain, char* lds) {
    int tid_ = ktid(); asm volatile("" : "+v"(tid_));
    const int lane = tid_ & 63, wid = __builtin_amdgcn_readfirstlane(tid_ >> 6), m31 = lane & 31, hh = lane >> 5;
    const int h = chain % C_HEADS, b = (chain / C_HEADS) % BATCH, dir = chain / (C_HEADS * BATCH);
    const unsigned char* gop = ws_at(wsb, WSO.GOP) + (size_t)chain * NCH * CHUNK_BYTES + lane * 16;
    float* obase = (float*)ws_at(wsb, WSO.OCD); const int ocol = h * HD + 32 * wid + m31;
    const unsigned lds0 = (unsigned)(uintptr_t)lds;
#define GDN_DMA(cc) do { if (wid >= 2) for (int f = wid - 2; f < FRAGS; f += 6) attn_body::glds16(gop + ((size_t)(cc) * FRAGS + f) * 1024, (unsigned)__builtin_amdgcn_readfirstlane(lds0 + ((cc) % 3) * CHUNK_BYTES + f * 1024)); } while (0)
    GDN_DMA(0); GDN_DMA(1);
    f32x16 s0 = {}, s1 = {};
    for (int cc = 0; cc < NCH; ++cc) {
        if (wid >= 2) { if (cc + 1 < NCH) asm volatile("s_waitcnt vmcnt(6)" ::: "memory"); else asm volatile("s_waitcnt vmcnt(0)" ::: "memory"); }
        asm volatile("s_waitcnt lgkmcnt(0)\n\ts_barrier" ::: "memory");
        if (cc + 2 < NCH) GDN_DMA(cc + 2);
        if (wid < 2) {
            const GLAS unsigned char* B = (const GLAS unsigned char*)lds + (cc % 3) * CHUNK_BYTES + lane * 16;
#define FR(f) (*(const GLAS bf16x8*)(B + (f) * 1024))
#define PK8(t, o) asfrag((u32x4){pk(t[o], t[o + 1]), pk(t[o + 2], t[o + 3]), pk(t[o + 4], t[o + 5]), pk(t[o + 6], t[o + 7])})
            const float sd = *(const GLAS float*)(B + 40 * 1024);
            const bf16x8 sB[4] = {PK8(s0, 0), PK8(s0, 8), PK8(s1, 0), PK8(s1, 8)};
            f32x16 vn[2];
#pragma unroll
            for (int a = 0; a < 2; ++a) { const u32x4 lo = *(const GLAS u32x4*)(B + (32 + (wid * 2 + a) * 2) * 1024), hi = *(const GLAS u32x4*)(B + (32 + (wid * 2 + a) * 2 + 1) * 1024);
#pragma unroll
                for (int e = 0; e < 4; ++e) { vn[a][2 * e] = blo(lo[e]); vn[a][2 * e + 1] = bhi(lo[e]); vn[a][8 + 2 * e] = blo(hi[e]); vn[a][8 + 2 * e + 1] = bhi(hi[e]); }
#pragma unroll
                for (int ks = 0; ks < 4; ++ks) vn[a] = __builtin_amdgcn_mfma_f32_32x32x16_bf16(FR(a * 4 + ks), sB[ks], vn[a], 0, 0, 0); }
            const bf16x8 vB[4] = {PK8(vn[0], 0), PK8(vn[0], 8), PK8(vn[1], 0), PK8(vn[1], 8)};
            f32x16 o[2];
#pragma unroll
            for (int a = 0; a < 2; ++a) { o[a] = (f32x16){};
#pragma unroll
                for (int ks = 0; ks < 4; ++ks) o[a] = __builtin_amdgcn_mfma_f32_32x32x16_bf16(FR(8 + a * 4 + ks), sB[ks], o[a], 0, 0, 0);
#pragma unroll
                for (int ks = 0; ks < 4; ++ks) o[a] = __builtin_amdgcn_mfma_f32_32x32x16_bf16(FR(16 + a * 4 + ks), vB[ks], o[a], 0, 0, 0); }
            s0 = s0 * sd; s1 = s1 * sd;
#pragma unroll
            for (int ks = 0; ks < 4; ++ks) { s0 = __builtin_amdgcn_mfma_f32_32x32x16_bf16(FR(24 + ks), vB[ks], s0, 0, 0, 0); s1 = __builtin_amdgcn_mfma_f32_32x32x16_bf16(FR(28 + ks), vB[ks], s1, 0, 0, 0); }
#pragma unroll
            for (int a = 0; a < 2; ++a)
#pragma unroll
                for (int r = 0; r < 16; ++r) { const int i = 32 * a + (r & 3) + 8 * (r >> 2) + 4 * hh; __builtin_nontemporal_store(o[a][r], &obase[(size_t)(dir * NTOK + chunk_row(dir, b, cc, i)) * C_W + ocol]); }
#undef FR
#undef PK8
        }
    }
    asm volatile("s_waitcnt vmcnt(0) lgkmcnt(0)\n\ts_barrier" ::: "memory");
#undef GDN_DMA
}
#undef GDN_FENCE
}

namespace rowp {
typedef float f32x4 __attribute__((ext_vector_type(4)));
typedef unsigned u32x4 __attribute__((ext_vector_type(4)));
typedef unsigned u32x2 __attribute__((ext_vector_type(2)));
typedef float f32x2_t __attribute__((ext_vector_type(2))); typedef __bf16 bf16x2_t __attribute__((ext_vector_type(2)));
#define RLAS __attribute__((address_space(3)))
__device__ __forceinline__ unsigned pk(float lo, float hi) { const f32x2_t v = {lo, hi}; return __builtin_bit_cast(unsigned, __builtin_convertvector(v, bf16x2_t)); }
__device__ __forceinline__ float blo(unsigned u) { return __uint_as_float(u << 16); }
__device__ __forceinline__ float bhi(unsigned u) { return __uint_as_float(u & 0xffff0000u); }
template <int CTRL> __device__ __forceinline__ float dppf(float v) { return __int_as_float(__builtin_amdgcn_update_dpp(0, __float_as_int(v), CTRL, 0xf, 0xf, true)); }
constexpr int DPP_X1 = 0xB1, DPP_X2 = 0x4E, DPP_HMIR = 0x141, DPP_MIR = 0x140;
struct F2 { float a, b; };
__device__ __forceinline__ F2 swap16(float x, float y) { auto rr = __builtin_amdgcn_permlane16_swap(__float_as_uint(x), __float_as_uint(y), false, false); return F2{__uint_as_float(rr[0]), __uint_as_float(rr[1])}; }
__device__ __forceinline__ F2 swap32(float x, float y) { auto rr = __builtin_amdgcn_permlane32_swap(__float_as_uint(x), __float_as_uint(y), false, false); return F2{__uint_as_float(rr[0]), __uint_as_float(rr[1])}; }
__device__ __forceinline__ float sum8(float v) { v += dppf<DPP_X1>(v); v += dppf<DPP_X2>(v); v += dppf<DPP_HMIR>(v); return v; }
__device__ __forceinline__ float wsum(float v, int) { v = sum8(v); v += dppf<DPP_MIR>(v); { const F2 r = swap16(v, v); v = r.a + r.b; } { const F2 r = swap32(v, v); v = r.a + r.b; } return v; }
__device__ __forceinline__ float fsilu(float x) { return x * __builtin_amdgcn_rcpf(1.0f + __expf(-x)); }
struct Lane { int tid, lane, wid; };
__device__ __forceinline__ Lane mk_lane() { int t = ktid(); asm volatile("" : "+v"(t)); Lane L; L.tid = t; L.lane = t & 63; L.wid = __builtin_amdgcn_readfirstlane(t >> 6); return L; }
static_assert(D_MODEL == 1024 && N_EXPERTS == 16 && C_HEADS == 8 && HD == 64, "row-phase geometry");
__device__ __forceinline__ void ln_stats(const f32x4 (&v)[4], float& mean, float& rstd, int lane) {
    float s = 0.f;
#pragma unroll
    for (int j = 0; j < 4; ++j) s += (v[j][0] + v[j][1]) + (v[j][2] + v[j][3]);
    mean = wsum(s, lane) * (1.0f / D_MODEL); float q = 0.f;
#pragma unroll
    for (int j = 0; j < 4; ++j) { const f32x4 d = v[j] - mean; q += (d[0] * d[0] + d[1] * d[1]) + (d[2] * d[2] + d[3] * d[3]); }
    rstd = 1.0f / sqrtf(wsum(q, lane) * (1.0f / D_MODEL) + LN_EPS);
}
__device__ __forceinline__ void store_mod_h(bf16_t* hrow, const f32x4 (&v)[4], float mean, float rstd, const float* sh, const float* sc, int lane) {
#pragma unroll
    for (int j = 0; j < 4; ++j) { const int c = 4 * lane + 256 * j; const f32x4 a = *(const f32x4*)(sc + c), b = *(const f32x4*)(sh + c); const f32x4 y = (v[j] - mean) * rstd * (a + 1.0f) + b;
        u32x2 o; o.x = pk(y[0], y[1]); o.y = pk(y[2], y[3]); *(u32x2*)(hrow + c) = o; }
}
__device__ __forceinline__ const float* xrow(const float* X, const float* const* in, int l, int r) {
    return l == 0 ? (r < NLAT ? in[0] + (size_t)r * D_MODEL : in[2] + (size_t)(r - NLAT) * D_MODEL) : X + (size_t)r * D_MODEL; }
__device__ __forceinline__ const float* modrow(const float* MOD, int l, int r, int which) { return MOD + (((size_t)l * (BATCH + 1) + mod_set(r)) * N_MOD + which) * D_MODEL; }

constexpr int IT_IN = (D_MODEL / 64) * (ZN / 32), IT_BR = (BRANCH_W / 64) * (D_MODEL / 32), IT_OUT = (D_MODEL / 64) * (D_MODEL / 32), IT_GU = (D_MODEL / 64) * (2 * D_EXPERT / 32), IT_DN = (D_EXPERT / 64) * (D_MODEL / 32);
constexpr int IT_LAYER = IT_IN + N_BRANCH * IT_BR + IT_OUT + N_EXPERTS * (IT_GU + IT_DN);
__device__ __forceinline__ void transpose_item(const float* S, int lds_, int scol0, bf16_t* D, int K, int drow0, int k0, RLAS float* scr, int lane) {
    f32x4 tv[8];
#pragma unroll
    for (int i = 0; i < 8; ++i) tv[i] = scol0 >= 0 ? *(const f32x4*)(S + (size_t)(k0 + 8 * i + (lane >> 3)) * lds_ + scol0 + 4 * (lane & 7)) : (f32x4){0.f, 0.f, 0.f, 0.f};
#pragma unroll
    for (int i = 0; i < 8; ++i)
#pragma unroll
        for (int e = 0; e < 4; ++e) scr[(8 * i + (lane >> 3)) * 33 + 4 * (lane & 7) + e] = tv[i][e];
    asm volatile("s_waitcnt lgkmcnt(0)" ::: "memory");
    const int ch = lane & 7;
#pragma unroll
    for (int j = 0; j < 4; ++j) { const int n = (lane >> 3) + 8 * j; const RLAS float* s = scr + (8 * ch) * 33 + n;
        u32x4 o; o.x = pk(s[0 * 33], s[1 * 33]); o.y = pk(s[2 * 33], s[3 * 33]); o.z = pk(s[4 * 33], s[5 * 33]); o.w = pk(s[6 * 33], s[7 * 33]);
        *(u32x4*)(D + (size_t)(drow0 + n) * K + k0 + 8 * ch) = o; }
    asm volatile("s_waitcnt lgkmcnt(0)" ::: "memory");
}
__device__ __forceinline__ void convert_item(unsigned char* wsb, const float* const* in, int l, int r, RLAS float* scr, int lane) {
        if (r < IT_IN) { const int nb = r % (ZN / 32), kb = r / (ZN / 32); const int o = zcol2orig(nb * 32);
            transpose_item(in[6] + (size_t)l * D_MODEL * D_IN, D_IN, o, (bf16_t*)ws_at(wsb, WSO.WinT) + (size_t)l * ZN * D_MODEL, D_MODEL, nb * 32, kb * 64, scr, lane); return; }
        r -= IT_IN;
        if (r < N_BRANCH * IT_BR) { const int br = r / IT_BR, q = r % IT_BR, nb = q % (D_MODEL / 32), kb = q / (D_MODEL / 32);
            transpose_item(in[13] + ((size_t)l * N_BRANCH + br) * BRANCH_W * D_MODEL, D_MODEL, nb * 32, (bf16_t*)ws_at(wsb, WSO.WbrT) + ((size_t)l * N_BRANCH + br) * D_MODEL * BRANCH_W, BRANCH_W, nb * 32, kb * 64, scr, lane); return; }
        r -= N_BRANCH * IT_BR;
        if (r < IT_OUT) { const int nb = r % (D_MODEL / 32), kb = r / (D_MODEL / 32);
            transpose_item(in[14] + (size_t)l * D_MODEL * D_MODEL, D_MODEL, nb * 32, (bf16_t*)ws_at(wsb, WSO.WoutT) + (size_t)l * D_MODEL * D_MODEL, D_MODEL, nb * 32, kb * 64, scr, lane); return; }
        r -= IT_OUT;
        if (r < N_EXPERTS * IT_GU) { const int e = r / IT_GU, q = r % IT_GU, nb = q % (2 * D_EXPERT / 32), kb = q / (2 * D_EXPERT / 32); const int row = nb * 32;
            const int blk = row / (2 * GU_BLK), rem = row % (2 * GU_BLK), half = rem / GU_BLK, col = half * D_EXPERT + blk * GU_BLK + rem % GU_BLK;
            transpose_item(in[18] + ((size_t)l * N_EXPERTS + e) * D_MODEL * 2 * D_EXPERT, 2 * D_EXPERT, col, (bf16_t*)ws_at(wsb, WSO.WguT) + ((size_t)l * N_EXPERTS + e) * 2 * D_EXPERT * D_MODEL, D_MODEL, row, kb * 64, scr, lane); return; }
        r -= N_EXPERTS * IT_GU;
        { const int e = r / IT_DN, q = r % IT_DN, nb = q % (D_MODEL / 32), kb = q / (D_MODEL / 32);
            transpose_item(in[19] + ((size_t)l * N_EXPERTS + e) * D_EXPERT * D_MODEL, D_MODEL, nb * 32, (bf16_t*)ws_at(wsb, WSO.WdnT) + ((size_t)l * N_EXPERTS + e) * D_MODEL * D_EXPERT, D_EXPERT, nb * 32, kb * 64, scr, lane); }
}
constexpr int CONV_UNIT = 16;
__device__ __forceinline__ void convert_queue(unsigned char* wsb, const float* const* in, unsigned* ctr, int l, int max_units, char* lds) {
    const Lane T = mk_lane(); const int lane = T.lane, wid = T.wid;
    RLAS float* scr = (RLAS float*)((RLAS char*)lds + wid * 16384);
    volatile RLAS unsigned* w = (volatile RLAS unsigned*)((RLAS char*)lds + 131072 + 128);
    for (int n = 0; max_units < 0 || n < max_units; ++n) {
        if (T.tid == 0) w[0] = __hip_atomic_fetch_add(ctr, 1u, __ATOMIC_RELAXED, __HIP_MEMORY_SCOPE_AGENT);
        __syncthreads(); const int u = (int)w[0]; __syncthreads();
        if (u * CONV_UNIT >= IT_LAYER) break;
        const int e_ = (u + 1) * CONV_UNIT < IT_LAYER ? (u + 1) * CONV_UNIT : IT_LAYER;
        for (int it = u * CONV_UNIT + wid; it < e_; it += 8) convert_item(wsb, in, l, it, scr, lane);
    }
    __syncthreads();
}
__device__ __forceinline__ void prologue_a(unsigned char* wsb, const float* const* in, char* lds, int G, int c) {
    const Lane T = mk_lane(); const int lane = T.lane, wid = T.wid;
    RLAS float* scr = (RLAS float*)((RLAS char*)lds + wid * 16384);
    const int gw = c * 8 + wid, NGW = G * 8;
#pragma unroll 1
    for (int step = 0; step < 2; ++step) { if (((c & 1) == 0) == (step == 0)) {
    for (int it = gw; it < IT_LAYER; it += NGW) convert_item(wsb, in, 0, it, scr, lane);
    { float* ROPE = (float*)ws_at(wsb, WSO.ROPE);
      for (int i = c * 512 + T.tid; i < ROPE_P * NFREQ; i += G * 512) { const int f = i % NFREQ, p = i / NFREQ; const float inv = exp2f(-(float)f / NFREQ * 13.287712379549449f);
        float s, cs; sincos_rr((float)p * inv, s, cs); ROPE[2 * i] = cs; ROPE[2 * i + 1] = s; } }
    } else
    { RLAS float* sil = (RLAS float*)lds;
      RLAS float* red = (RLAS float*)((RLAS char*)lds + 40960);
      for (int i = T.tid; i < (BATCH + 1) * D_MODEL; i += 512) { const int s = i / D_MODEL, k = i % D_MODEL; const float v = s < BATCH ? in[1][s * D_MODEL + k] : in[3][k]; sil[i] = fsilu(v); }
      __syncthreads();
      float* MOD = (float*)ws_at(wsb, WSO.MOD);
      for (int task = c; task < DEPTH * (N_MOD * D_MODEL / 64); task += G) { const int l = task / (N_MOD * D_MODEL / 64), j = (task % (N_MOD * D_MODEL / 64)) * 64 + lane;
        const float* wm = in[4] + (size_t)l * D_MODEL * N_MOD * D_MODEL + j; float acc[BATCH + 1];
#pragma unroll
        for (int s = 0; s <= BATCH; ++s) acc[s] = 0.f;
        for (int k0 = wid * 128; k0 < wid * 128 + 128; k0 += 16) { float wv[16];
#pragma unroll
            for (int q = 0; q < 16; ++q) wv[q] = wm[(size_t)(k0 + q) * N_MOD * D_MODEL];
#pragma unroll
            for (int q = 0; q < 16; ++q)
#pragma unroll
                for (int s = 0; s <= BATCH; ++s) acc[s] += sil[s * D_MODEL + k0 + q] * wv[q]; }
#pragma unroll
        for (int s = 0; s <= BATCH; ++s) red[(wid * (BATCH + 1) + s) * 64 + lane] = acc[s];
        __syncthreads();
        for (int i = T.tid; i < (BATCH + 1) * 64; i += 512) { const int s = i / 64, jj = i % 64; float t = in[5][(size_t)l * N_MOD * D_MODEL + (task % (N_MOD * D_MODEL / 64)) * 64 + jj];
#pragma unroll
            for (int w = 0; w < 8; ++w) t += red[(w * (BATCH + 1) + s) * 64 + jj];
            MOD[((size_t)l * (BATCH + 1) + s) * N_MOD * D_MODEL + (task % (N_MOD * D_MODEL / 64)) * 64 + jj] = t; }
        __syncthreads(); }
    }
    __syncthreads(); }
}
__device__ __forceinline__ void prologue_b(unsigned char* wsb, const float* const* in, char* lds, int G, int c) {
    const Lane T = mk_lane(); const int lane = T.lane;
    float* X = (float*)ws_at(wsb, WSO.X); bf16_t* H = (bf16_t*)ws_at(wsb, WSO.H); const float* MOD = (const float*)ws_at(wsb, WSO.MOD);
    RLAS float* cmod = (RLAS float*)lds;
    const int per = (NTOK + G - 1) / G, rbeg = c * per, rend = rbeg + per < NTOK ? rbeg + per : NTOK;
    const int set0 = mod_set(rbeg < NTOK ? rbeg : 0), set1 = mod_set(rend > rbeg ? rend - 1 : 0);
    { float t_[8];
#pragma unroll
      for (int u = 0; u < 8; ++u) { const int i = T.tid + 512 * u, s = i / (2 * D_MODEL), wh = (i / D_MODEL) % 2, k = i % D_MODEL; t_[u] = MOD[(((size_t)(s ? set1 : set0)) * N_MOD + wh) * D_MODEL + k]; }
#pragma unroll
      for (int u = 0; u < 8; ++u) cmod[T.tid + 512 * u] = t_[u]; }
    __syncthreads();
#define PB_SRC(rr) ((rr) < NLAT ? in[0] + (size_t)(rr) * D_MODEL : in[2] + (size_t)((rr) - NLAT) * D_MODEL)
    f32x4 nv[4];
    { const int r0 = rbeg + T.wid; if (r0 < rend) { const float* src = PB_SRC(r0);
#pragma unroll
        for (int j = 0; j < 4; ++j) nv[j] = *(const f32x4*)(src + 4 * lane + 256 * j); } }
    for (int r = rbeg + T.wid; r < rend; r += 8) { f32x4 v[4];
#pragma unroll
        for (int j = 0; j < 4; ++j) v[j] = nv[j];
        if (r + 8 < rend) { const float* src = PB_SRC(r + 8);
#pragma unroll
            for (int j = 0; j < 4; ++j) nv[j] = *(const f32x4*)(src + 4 * lane + 256 * j); }
        (void)X;
        float mean, rstd; ln_stats(v, mean, rstd, lane);
        const RLAS float* cm = cmod + (mod_set(r) == set0 ? 0 : 2 * D_MODEL);
#pragma unroll
        for (int j = 0; j < 4; ++j) { const int cc = 4 * lane + 256 * j; const f32x4 y = (v[j] - mean) * rstd * (*(const RLAS f32x4*)(cm + D_MODEL + cc) + 1.0f) + *(const RLAS f32x4*)(cm + cc);
            u32x2 o; o.x = pk(y[0], y[1]); o.y = pk(y[2], y[3]); *(u32x2*)(H + (size_t)r * D_MODEL + cc) = o; } }
#undef PB_SRC
}
__device__ __forceinline__ void prep_phase(unsigned char* wsb, const float* const* in, int l, char* lds, int G, int c) {
    const Lane T = mk_lane(); const int lane = T.lane, sub = lane & 7;
    const bf16_t* Z = (const bf16_t*)ws_at(wsb, WSO.Z); const float* ROPE = (const float*)ws_at(wsb, WSO.ROPE);
    bf16_t* QA = (bf16_t*)ws_at(wsb, WSO.QA); bf16_t* KA = (bf16_t*)ws_at(wsb, WSO.KA); bf16_t* VA = (bf16_t*)ws_at(wsb, WSO.VA);
    bf16_t* QC = (bf16_t*)ws_at(wsb, WSO.QC); bf16_t* KC = (bf16_t*)ws_at(wsb, WSO.KC); bf16_t* VC = (bf16_t*)ws_at(wsb, WSO.VC);
    float* Gd = (float*)ws_at(wsb, WSO.G); float* Bd = (float*)ws_at(wsb, WSO.BETA);
    const float* qk_gain = in[7] + (size_t)l * 2 * HD; const float* conv_w = in[9] + (size_t)l * CONV_K * 3 * C_W;
    float cw[3][CONV_K][8], gq[8], gk[8];
#pragma unroll
    for (int p = 0; p < 3; ++p)
#pragma unroll
        for (int j = 0; j < CONV_K; ++j) { const float* wv = conv_w + (size_t)j * 3 * C_W + p * C_W + 8 * lane; const f32x4 w0 = *(const f32x4*)wv, w1 = *(const f32x4*)(wv + 4);
#pragma unroll
            for (int e = 0; e < 4; ++e) { cw[p][j][e] = w0[e]; cw[p][j][4 + e] = w1[e]; } }
#pragma unroll
    for (int e = 0; e < 8; ++e) { gq[e] = qk_gain[8 * sub + e]; gk[e] = qk_gain[HD + 8 * sub + e]; }
    const float mya = lane < 2 * C_HEADS ? -__expf(in[10][(size_t)l * 2 * C_HEADS + lane]) : 0.f, mydt = lane < 2 * C_HEADS ? in[11][(size_t)l * 2 * C_HEADS + lane] : 0.f;
    const int gw = c * 8 + T.wid, per = (NTOK + G * 8 - 1) / (G * 8), rbeg = gw * per, rend = rbeg + per < NTOK ? rbeg + per : NTOK;
    const u32x4 zero4 = {0u, 0u, 0u, 0u};
    u32x4 win[3][5];
#define PREP_LDROW(rr, p) (*(const u32x4*)(Z + (size_t)((rr) < 0 ? 0 : (rr) >= NTOK ? NTOK - 1 : (rr)) * ZN + ZC_QKVC + (p) * C_W + 8 * lane))
    RLAS float* ropel = (RLAS float*)lds;
    { float t_[ROPE_P * NFREQ * 2 / 512];
#pragma unroll
      for (int u = 0; u < ROPE_P * NFREQ * 2 / 512; ++u) t_[u] = ROPE[T.tid + 512 * u];
#pragma unroll
      for (int u = 0; u < ROPE_P * NFREQ * 2 / 512; ++u) ropel[T.tid + 512 * u] = t_[u]; }
    static_assert(ROPE_P * NFREQ * 2 % 512 == 0, "rope table fill");
    __syncthreads();
    u32x4 nq = zero4, nkv = zero4; bf16_t na = 0, nb = 0;
#define PREP_LDNEXT(rr) do { const bf16_t* zn_ = Z + (size_t)(rr) * ZN; nq = *(const u32x4*)(zn_ + ZC_QA + 8 * lane); if (lane < 32) nkv = *(const u32x4*)(zn_ + (lane < 16 ? ZC_KA + 8 * lane : ZC_VA + 8 * (lane - 16))); \
        if (lane < 2 * C_HEADS) { na = zn_[ZC_A + lane]; nb = zn_[ZC_B + lane]; } } while (0)
    if (rbeg < rend) {
#pragma unroll
        for (int p = 0; p < 3; ++p)
#pragma unroll
            for (int j = 0; j < 4; ++j) win[p][j + 1] = PREP_LDROW(rbeg + j - 2, p);
        PREP_LDNEXT(rbeg); }
    for (int r = rbeg; r < rend; ++r) {
        const u32x4 rawq = nq, rawkv = nkv; const bf16_t ra = na, rb = nb;
#pragma unroll
        for (int p = 0; p < 3; ++p) {
#pragma unroll
            for (int j = 0; j < 4; ++j) win[p][j] = win[p][j + 1];
            win[p][4] = PREP_LDROW(r + 2, p); }
        if (r + 1 < rend) PREP_LDNEXT(r + 1);
        const bool lat = r < NLAT; const int b = lat ? r / SEQ : (r - NLAT) / CTX_LEN, t = lat ? r % SEQ : (r - NLAT) % CTX_LEN, len = lat ? SEQ : CTX_LEN;
        const int kvr = lat ? t : SEQ + t;
#pragma unroll
        for (int pass = 0; pass < 2; ++pass) {
            if (pass == 1 && lane >= 16) { if (lane < 32) *(u32x4*)(VA + ((size_t)(b * A_KV_HEADS + ((lane - 16) >> 3)) * KVLEN + kvr) * HD + 8 * (lane & 7)) = rawkv; continue; }
            const u32x4 raw = pass == 0 ? rawq : rawkv; float v[8];
#pragma unroll
            for (int e = 0; e < 4; ++e) { v[2 * e] = blo(raw[e]); v[2 * e + 1] = bhi(raw[e]); }
            float ss = 0.f;
#pragma unroll
            for (int e = 0; e < 8; ++e) ss += v[e] * v[e];
            ss = sum8(ss);
            const float rs = 1.0f / sqrtf(ss * (1.0f / HD) + LN_EPS);
#pragma unroll
            for (int e = 0; e < 8; ++e) v[e] = v[e] * rs * (pass == 0 ? gq[e] : gk[e]);
            if (lat) { const int quarter = sub >> 1, f0 = (8 * sub) & 15;
                const RLAS float* tab = ropel + (quarter < 2 ? t / GRID_W : t % GRID_W) * NFREQ * 2 + 2 * f0;
#pragma unroll
                for (int e = 0; e < 8; ++e) { const float other = dppf<DPP_X2>(v[e]), cs = tab[2 * e], sn = tab[2 * e + 1]; v[e] = (quarter & 1) ? v[e] * cs + other * sn : v[e] * cs - other * sn; } }
            u32x4 o;
            if (pass == 0) { o.x = pk(v[0] * QSCALE, v[1] * QSCALE); o.y = pk(v[2] * QSCALE, v[3] * QSCALE); o.z = pk(v[4] * QSCALE, v[5] * QSCALE); o.w = pk(v[6] * QSCALE, v[7] * QSCALE); *(u32x4*)(QA + (size_t)r * A_Q_W + 8 * lane) = o; }
            else { o.x = pk(v[0], v[1]); o.y = pk(v[2], v[3]); o.z = pk(v[4], v[5]); o.w = pk(v[6], v[7]); *(u32x4*)(KA + ((size_t)(b * A_KV_HEADS + (lane >> 3)) * KVLEN + kvr) * HD + 8 * (lane & 7)) = o; }
        }
#pragma unroll
        for (int part = 0; part < 3; ++part) { float y[8];
#pragma unroll
            for (int e = 0; e < 8; ++e) y[e] = 0.f;
#pragma unroll
            for (int j = 0; j < CONV_K; ++j) { const int tt = t + j - CONV_K / 2; const float m = (tt >= 0 && tt < len) ? 1.0f : 0.0f; const u32x4 raw = win[part][j];
#pragma unroll
                for (int e = 0; e < 4; ++e) { y[2 * e] += blo(raw[e]) * (cw[part][j][2 * e] * m); y[2 * e + 1] += bhi(raw[e]) * (cw[part][j][2 * e + 1] * m); } }
            float ss = 0.f;
#pragma unroll
            for (int e = 0; e < 8; ++e) { y[e] = fsilu(y[e]); ss += y[e] * y[e]; }
            ss = sum8(ss);
            const float sc = part == 0 ? 0.125f / sqrtf(ss + LN_EPS) : part == 1 ? 1.0f / sqrtf(ss + LN_EPS) : 1.0f;
            u32x4 o; o.x = pk(y[0] * sc, y[1] * sc); o.y = pk(y[2] * sc, y[3] * sc); o.z = pk(y[4] * sc, y[5] * sc); o.w = pk(y[6] * sc, y[7] * sc);
            *(u32x4*)((part == 0 ? QC : part == 1 ? KC : VC) + (size_t)r * C_W + 8 * lane) = o; }
        if (lane < 2 * C_HEADS) { const float a = bf2f(ra), bt = bf2f(rb); const float x = a + mydt;
            Gd[(size_t)r * 2 * C_HEADS + lane] = mya * (x > 20.f ? x : ({ const float ex_ = __expf(x); ex_ < 0.03125f ? ex_ * (1.0f - ex_ * (0.5f - ex_ * 0.33333334f)) : __logf(1.0f + ex_); })); Bd[(size_t)r * 2 * C_HEADS + lane] = 1.0f / (1.0f + __expf(-bt)); }
    }
#undef PREP_LDROW
#undef PREP_LDNEXT
}
__device__ __forceinline__ void gdn_fin_rows(unsigned char* wsb, const float* const* in, int l, int rfirst, int rstep, int nrows) {
    const Lane T = mk_lane(); const int lane = T.lane, sub = lane & 7;
    const float* OCD = (const float*)ws_at(wsb, WSO.OCD); const bf16_t* Z = (const bf16_t*)ws_at(wsb, WSO.Z); bf16_t* OC = (bf16_t*)ws_at(wsb, WSO.OC); const float* og = in[12] + (size_t)l * HD + 8 * sub;
    f32x4 na0, na1, nb0, nb1; u32x4 ngt;
    { const int r0 = rfirst + T.wid; if (r0 < nrows) { const float* p0 = OCD + (size_t)r0 * C_W + 8 * lane; const float* p1 = p0 + (size_t)NTOK * C_W;
        na0 = *(const f32x4*)p0; na1 = *(const f32x4*)(p0 + 4); nb0 = *(const f32x4*)p1; nb1 = *(const f32x4*)(p1 + 4); ngt = *(const u32x4*)(Z + (size_t)r0 * ZN + ZC_GC + 8 * lane); } }
    for (int r = rfirst + T.wid; r < nrows; r += rstep) { float o[8];
        const f32x4 a0 = na0, a1 = na1, b0 = nb0, b1 = nb1; const u32x4 gt = ngt;
        if (r + rstep < nrows) { const float* p0 = OCD + (size_t)(r + rstep) * C_W + 8 * lane; const float* p1 = p0 + (size_t)NTOK * C_W;
            na0 = *(const f32x4*)p0; na1 = *(const f32x4*)(p0 + 4); nb0 = *(const f32x4*)p1; nb1 = *(const f32x4*)(p1 + 4); ngt = *(const u32x4*)(Z + (size_t)(r + rstep) * ZN + ZC_GC + 8 * lane); }
#pragma unroll
        for (int e = 0; e < 4; ++e) { o[e] = a0[e] + b0[e]; o[4 + e] = a1[e] + b1[e]; }
        float ss = 0.f;
#pragma unroll
        for (int e = 0; e < 8; ++e) ss += o[e] * o[e];
        ss = sum8(ss);
        const float rs = 1.0f / sqrtf(ss * (1.0f / HD) + LN_EPS);
        u32x4 out;
#pragma unroll
        for (int e = 0; e < 4; ++e) out[e] = pk(o[2 * e] * rs * og[2 * e] * fsilu(blo(gt[e])), o[2 * e + 1] * rs * og[2 * e + 1] * fsilu(bhi(gt[e])));
        *(u32x4*)(OC + (size_t)r * BRANCH_W + 8 * lane) = out; }
}
__device__ __forceinline__ void ln1_phase(unsigned char* wsb, const float* const* in, int l, float alpha, int nrows, char* lds, int G, int c) {
    const Lane T = mk_lane(); const int lane = T.lane;
    float* X = (float*)ws_at(wsb, WSO.X); bf16_t* H = (bf16_t*)ws_at(wsb, WSO.H); const float* MOD = (const float*)ws_at(wsb, WSO.MOD); float* AFFT = (float*)ws_at(wsb, WSO.AFF); const bf16_t* MIX = (const bf16_t*)ws_at(wsb, WSO.OA);
    const float* g1 = in[15] + (size_t)l * D_MODEL; const float* b1 = in[16] + (size_t)l * D_MODEL; const float* wr = in[17] + (size_t)l * D_MODEL * N_EXPERTS;
    RLAS float* wrt = (RLAS float*)lds;
    RLAS float* cg1 = wrt + N_EXPERTS * D_MODEL; RLAS float* cb1 = cg1 + D_MODEL; RLAS float* cmod = cb1 + D_MODEL;
    const int per = (nrows + G - 1) / G, rbeg = c * per, rend = rbeg + per < nrows ? rbeg + per : nrows;
    const int set0 = mod_set(rbeg < nrows ? rbeg : 0), set1 = mod_set(rend > rbeg ? rend - 1 : 0);
    for (int k = T.tid; k < D_MODEL; k += 512) { f32x4 t_[4];
#pragma unroll
        for (int u = 0; u < 4; ++u) t_[u] = *(const f32x4*)(wr + (size_t)k * N_EXPERTS + 4 * u);
#pragma unroll
        for (int u = 0; u < 4; ++u)
#pragma unroll
            for (int e = 0; e < 4; ++e) wrt[(4 * u + e) * D_MODEL + k] = t_[u][e]; }
    { float t_[16];
#pragma unroll
      for (int u = 0; u < 2; ++u) { t_[u] = g1[T.tid + 512 * u]; t_[2 + u] = b1[T.tid + 512 * u]; }
#pragma unroll
      for (int u = 0; u < 12; ++u) { const int i = T.tid + 512 * u, s = i / (3 * D_MODEL), wh = (i / D_MODEL) % 3, k = i % D_MODEL; t_[4 + u] = MOD[(((size_t)l * (BATCH + 1) + (s ? set1 : set0)) * N_MOD + 2 + wh) * D_MODEL + k]; }
#pragma unroll
      for (int u = 0; u < 2; ++u) { cg1[T.tid + 512 * u] = t_[u]; cb1[T.tid + 512 * u] = t_[2 + u]; }
#pragma unroll
      for (int u = 0; u < 12; ++u) cmod[T.tid + 512 * u] = t_[4 + u]; }
    static_assert(D_MODEL == 1024 && N_EXPERTS == 16, "LN1 fill shapes");
    __syncthreads();
    f32x4 wc0[N_EXPERTS];
#pragma unroll
    for (int e = 0; e < N_EXPERTS; ++e) wc0[e] = *(const RLAS f32x4*)(wrt + e * D_MODEL + 4 * lane);
    f32x4 nv[4]; u32x2 nm[4];
    { const int r0 = rbeg + T.wid; if (r0 < rend) {
#pragma unroll
        for (int j = 0; j < 4; ++j) { nv[j] = *(const f32x4*)(xrow(X, in, l, r0) + 4 * lane + 256 * j); nm[j] = *(const u32x2*)(MIX + (size_t)r0 * D_MODEL + 4 * lane + 256 * j); } } }
    for (int r = rbeg + T.wid; r < rend; r += 8) { f32x4 v[4]; u32x2 mxv[4];
#pragma unroll
        for (int j = 0; j < 4; ++j) { v[j] = nv[j]; mxv[j] = nm[j]; }
        if (r + 8 < rend) {
#pragma unroll
            for (int j = 0; j < 4; ++j) { nv[j] = *(const f32x4*)(xrow(X, in, l, r + 8) + 4 * lane + 256 * j); nm[j] = *(const u32x2*)(MIX + (size_t)(r + 8) * D_MODEL + 4 * lane + 256 * j); } }
        const RLAS float* cm = cmod + (mod_set(r) == set0 ? 0 : 3 * D_MODEL);
#pragma unroll
        for (int j = 0; j < 4; ++j) { const int cc = 4 * lane + 256 * j; const u32x2 w2 = mxv[j]; const f32x4 g = *(const RLAS f32x4*)(cm + cc);
            v[j][0] = alpha * v[j][0] + g[0] * blo(w2.x); v[j][1] = alpha * v[j][1] + g[1] * bhi(w2.x); v[j][2] = alpha * v[j][2] + g[2] * blo(w2.y); v[j][3] = alpha * v[j][3] + g[3] * bhi(w2.y); }
        float mean, rstd; ln_stats(v, mean, rstd, lane);
#pragma unroll
        for (int j = 0; j < 4; ++j) { const int cc = 4 * lane + 256 * j; v[j] = (v[j] - mean) * rstd * *(const RLAS f32x4*)(cg1 + cc) + *(const RLAS f32x4*)(cb1 + cc); }
        ln_stats(v, mean, rstd, lane);
        float lg[N_EXPERTS];
#pragma unroll
        for (int e = 0; e < N_EXPERTS; ++e) lg[e] = 0.f;
#pragma unroll
        for (int j = 0; j < 4; ++j) { const int cc = 4 * lane + 256 * j; const f32x4 y = (v[j] - mean) * rstd * (*(const RLAS f32x4*)(cm + 2 * D_MODEL + cc) + 1.0f) + *(const RLAS f32x4*)(cm + D_MODEL + cc);
            u32x2 o; o.x = pk(y[0], y[1]); o.y = pk(y[2], y[3]); *(u32x2*)(H + (size_t)r * D_MODEL + cc) = o;
            f32x4 w4[N_EXPERTS];
#pragma unroll
            for (int e = 0; e < N_EXPERTS; ++e) w4[e] = j == 0 ? wc0[e] : *(const RLAS f32x4*)(wrt + e * D_MODEL + cc);
            asm volatile("" ::: "memory");
#pragma unroll
            for (int e = 0; e < N_EXPERTS; ++e) lg[e] += (y[0] * w4[e][0] + y[1] * w4[e][1]) + (y[2] * w4[e][2] + y[3] * w4[e][3]);
            asm volatile("" ::: "memory"); }
        float a1;
        { float a8[8], a4[4], a2[2];
#pragma unroll
          for (int i = 0; i < 8; ++i) { const F2 r = swap32(lg[i], lg[8 + i]); a8[i] = r.a + r.b; }
#pragma unroll
          for (int i = 0; i < 4; ++i) { const F2 r = swap16(a8[i], a8[4 + i]); a4[i] = r.a + r.b; }
#pragma unroll
          for (int i = 0; i < 2; ++i) { const float snd = (lane & 8) ? a4[i] : a4[2 + i], kp = (lane & 8) ? a4[2 + i] : a4[i]; a2[i] = kp + dppf<DPP_MIR>(snd); }
          { const float snd = (lane & 4) ? a2[0] : a2[1], kp = (lane & 4) ? a2[1] : a2[0]; a1 = kp + dppf<DPP_HMIR>(snd); }
          a1 += dppf<DPP_X2>(a1); a1 += dppf<DPP_X1>(a1); }
        static_assert(N_EXPERTS == 16, "halving exchange is written for sixteen experts");
        float mx = a1;
        mx = fmaxf(mx, dppf<DPP_HMIR>(mx)); mx = fmaxf(mx, dppf<DPP_MIR>(mx)); { const F2 r = swap16(mx, mx); mx = fmaxf(r.a, r.b); } { const F2 r = swap32(mx, mx); mx = fmaxf(r.a, r.b); }
        const float pe = __expf(a1 - mx); float sm = pe;
        sm += dppf<DPP_HMIR>(sm); sm += dppf<DPP_MIR>(sm); { const F2 r = swap16(sm, sm); sm = r.a + r.b; } { const F2 r = swap32(sm, sm); sm = r.a + r.b; }
        if ((lane & 3) == 0) AFFT[(size_t)(lane >> 2) * NTOK + r] = pe / sm; }
    __syncthreads();
}
__device__ __forceinline__ void topk_phase(unsigned char* wsb, int ngroups, char* lds, int G, int c) {
    const Lane T = mk_lane(); const int tid = T.tid, lane = T.lane, wid = T.wid;
    const float* AFFT = (const float*)ws_at(wsb, WSO.AFF); int* TOKLIST = (int*)ws_at(wsb, WSO.TOKLIST); float* GATEV = (float*)ws_at(wsb, WSO.GATEV); int* SLOTOF = (int*)ws_at(wsb, WSO.SLOTOF);
    const bf16_t* H = (const bf16_t*)ws_at(wsb, WSO.H); bf16_t* XS = (bf16_t*)ws_at(wsb, WSO.XS);
    RLAS unsigned* hist = (RLAS unsigned*)lds;
    RLAS unsigned* sh = hist + 256;
    RLAS int* toks = (RLAS int*)(hist + 512);
    for (int g = c; g < ngroups; g += G) {
        const bool lat = g < BATCH * N_EXPERTS; const int gg = lat ? g : g - BATCH * N_EXPERTS, b = gg / N_EXPERTS, e = gg % N_EXPERTS;
        const int len = lat ? SEQ : CTX_LEN, cap = lat ? CAP_L : CAP_C, base = lat ? b * SEQ : NLAT + b * CTX_LEN, slot0 = lat ? (e * BATCH + b) * CAP_L : NSLOT_L + (e * BATCH + b) * CAP_C;
        constexpr int VPT = SEQ / 512; const int nv = lat ? VPT : (tid < CTX_LEN ? 1 : 0), i0 = lat ? tid * VPT : tid;
        unsigned key[VPT];
#pragma unroll
        for (int j = 0; j < VPT; ++j) key[j] = j < nv ? __float_as_uint(AFFT[(size_t)e * NTOK + base + i0 + j]) : 0u;
        unsigned prefix = 0u, want = (unsigned)cap;
#pragma unroll
        for (int pass = 0; pass < 4; ++pass) { const int shft = 24 - 8 * pass; const unsigned himask = pass == 0 ? 0u : (0xffffffffu << (shft + 8));
            if (tid < 256) hist[tid] = 0u;
            __syncthreads();
#pragma unroll
            for (int j = 0; j < VPT; ++j) if (j < nv && (key[j] & himask) == prefix) __hip_atomic_fetch_add(&hist[(key[j] >> shft) & 255u], 1u, __ATOMIC_RELAXED, __HIP_MEMORY_SCOPE_WORKGROUP);
            __syncthreads();
            if (wid == 0) {
                unsigned cnt[4]; unsigned tot = 0u;
#pragma unroll
                for (int q = 0; q < 4; ++q) { cnt[q] = hist[255 - (4 * lane + q)]; tot += cnt[q]; }
                unsigned incl = tot;
#pragma unroll
                for (int o = 1; o < 64; o <<= 1) { const unsigned t = shu_idx(incl, lane - o); if (lane >= o) incl += t; }
                unsigned before = incl - tot;
#pragma unroll
                for (int q = 0; q < 4; ++q) { if (before < want && want <= before + cnt[q]) { sh[0] = prefix | ((unsigned)(255 - (4 * lane + q)) << shft); sh[1] = want - before; } before += cnt[q]; }
            }
            __syncthreads();
            prefix = sh[0]; want = sh[1];
            __syncthreads(); }
        const unsigned thr = prefix; const unsigned need_eq = want;
        unsigned ngt = 0u, neq = 0u;
#pragma unroll
        for (int j = 0; j < VPT; ++j) if (j < nv) { ngt += key[j] > thr ? 1u : 0u; neq += key[j] == thr ? 1u : 0u; }
        unsigned igt = ngt, ieq = neq;
#pragma unroll
        for (int o = 1; o < 64; o <<= 1) { const unsigned t0 = shu_idx(igt, lane - o), t1 = shu_idx(ieq, lane - o); if (lane >= o) { igt += t0; ieq += t1; } }
        if (lane == 63) { sh[8 + wid] = igt; sh[16 + wid] = ieq; }
        __syncthreads();
        unsigned ogt = igt - ngt, oeq = ieq - neq;
#pragma unroll
        for (int w = 0; w < 8; ++w) if (w < wid) { ogt += sh[8 + w]; oeq += sh[16 + w]; }
#pragma unroll
        for (int j = 0; j < VPT; ++j) if (j < nv) { const bool gt = key[j] > thr, eq = key[j] == thr; const bool sel = gt || (eq && oeq < need_eq);
            const unsigned eq_before = oeq < need_eq ? oeq : need_eq; const int pos = (int)(ogt + eq_before); const int r = base + i0 + j;
            if (sel) { TOKLIST[slot0 + pos] = r; GATEV[slot0 + pos] = __uint_as_float(key[j]); }
            SLOTOF[(size_t)r * N_EXPERTS + e] = sel ? slot0 + pos : -1;
            ogt += gt ? 1u : 0u; oeq += eq ? 1u : 0u; }
        __syncthreads();
        __syncthreads();
    }
}
__device__ __forceinline__ void ln2_phase(unsigned char* wsb, const float* const* in, float* out, int l, float alpha, char* lds, int G, int c) {
    const Lane T = mk_lane(); const int lane = T.lane;
    const bf16_t* MIX = (const bf16_t*)ws_at(wsb, WSO.OA); const float* g1 = in[15] + (size_t)l * D_MODEL; const float* b1 = in[16] + (size_t)l * D_MODEL;
    float* X = (float*)ws_at(wsb, WSO.X); bf16_t* H = (bf16_t*)ws_at(wsb, WSO.H); const float* MOD = (const float*)ws_at(wsb, WSO.MOD); const int* SLOTOF = (const int*)ws_at(wsb, WSO.SLOTOF); const bf16_t* YS = (const bf16_t*)ws_at(wsb, WSO.YS);
    const float* g2 = in[20] + (size_t)l * D_MODEL; const float* b2 = in[21] + (size_t)l * D_MODEL;
    const int nrows = l == DEPTH - 1 ? NLAT : NTOK;
    RLAS float* cg = (RLAS float*)lds;
    RLAS float* cmod = cg + 4 * D_MODEL;
    const int per = (nrows + G - 1) / G, rbeg = c * per, rend = rbeg + per < nrows ? rbeg + per : nrows;
    const int set0 = mod_set(rbeg < nrows ? rbeg : 0), set1 = mod_set(rend > rbeg ? rend - 1 : 0);
    { float t_[24];
#pragma unroll
      for (int u = 0; u < 8; ++u) { const int i = T.tid + 512 * u, wh = i / D_MODEL, k = i % D_MODEL; t_[u] = (wh == 0 ? g1 : wh == 1 ? b1 : wh == 2 ? g2 : b2)[k]; }
#pragma unroll
      for (int u = 0; u < 16; ++u) { const int i = T.tid + 512 * u, s = i / (4 * D_MODEL), wh = (i / D_MODEL) % 4, k = i % D_MODEL; const int ll = wh < 2 ? l : l + 1, which = wh == 0 ? 2 : wh == 1 ? 5 : wh - 2;
          t_[8 + u] = ll < DEPTH ? MOD[(((size_t)ll * (BATCH + 1) + (s ? set1 : set0)) * N_MOD + which) * D_MODEL + k] : 0.f; }
#pragma unroll
      for (int u = 0; u < 8; ++u) cg[T.tid + 512 * u] = t_[u];
#pragma unroll
      for (int u = 0; u < 16; ++u) cmod[T.tid + 512 * u] = t_[8 + u]; }
    __syncthreads();
    f32x4 nv[4]; u32x2 nm[4], ny[2][4]; int nslot = -1, nslot2 = -1;
#define LN2_LDY(sl) do { unsigned long long m_ = __builtin_amdgcn_ballot_w64((sl) >= 0); _Pragma("unroll") for (int q_ = 0; q_ < 2; ++q_) { if (m_) { const int e_ = __builtin_ctzll(m_); m_ &= m_ - 1; \
            const bf16_t* ys_ = YS + (size_t)shi_idx((sl), e_) * D_MODEL; _Pragma("unroll") for (int j = 0; j < 4; ++j) ny[q_][j] = *(const u32x2*)(ys_ + 4 * lane + 256 * j); } } } while (0)
    { const int r0 = rbeg + T.wid; if (r0 < rend) { nslot = lane < N_EXPERTS ? SLOTOF[(size_t)r0 * N_EXPERTS + lane] : -1; if (r0 + 8 < rend) nslot2 = lane < N_EXPERTS ? SLOTOF[(size_t)(r0 + 8) * N_EXPERTS + lane] : -1;
#pragma unroll
        for (int j = 0; j < 4; ++j) { nv[j] = *(const f32x4*)(xrow(X, in, l, r0) + 4 * lane + 256 * j); nm[j] = *(const u32x2*)(MIX + (size_t)r0 * D_MODEL + 4 * lane + 256 * j); }
        LN2_LDY(nslot); } }
    for (int r = rbeg + T.wid; r < rend; r += 8) {
        float* xr = X + (size_t)r * D_MODEL; f32x4 v[4], moe[4]; u32x2 mxv[4], yv[2][4];
#pragma unroll
        for (int j = 0; j < 4; ++j) { v[j] = nv[j]; mxv[j] = nm[j]; moe[j] = (f32x4){0.f, 0.f, 0.f, 0.f}; yv[0][j] = ny[0][j]; yv[1][j] = ny[1][j]; }
        const int myslot = nslot; nslot = nslot2;
        if (r + 8 < rend) { nslot2 = (r + 16 < rend && lane < N_EXPERTS) ? SLOTOF[(size_t)(r + 16) * N_EXPERTS + lane] : -1;
#pragma unroll
            for (int j = 0; j < 4; ++j) { nv[j] = *(const f32x4*)(xrow(X, in, l, r + 8) + 4 * lane + 256 * j); nm[j] = *(const u32x2*)(MIX + (size_t)(r + 8) * D_MODEL + 4 * lane + 256 * j); }
            LN2_LDY(nslot); }
        const RLAS float* cm = cmod + (mod_set(r) == set0 ? 0 : 4 * D_MODEL);
        {
#pragma unroll
          for (int j = 0; j < 4; ++j) { const int cc = 4 * lane + 256 * j; const u32x2 w2 = mxv[j]; const f32x4 g = *(const RLAS f32x4*)(cm + cc);
              v[j][0] = alpha * v[j][0] + g[0] * blo(w2.x); v[j][1] = alpha * v[j][1] + g[1] * bhi(w2.x); v[j][2] = alpha * v[j][2] + g[2] * blo(w2.y); v[j][3] = alpha * v[j][3] + g[3] * bhi(w2.y); }
          float mean1, rstd1; ln_stats(v, mean1, rstd1, lane);
#pragma unroll
          for (int j = 0; j < 4; ++j) { const int cc = 4 * lane + 256 * j; v[j] = (v[j] - mean1) * rstd1 * *(const RLAS f32x4*)(cg + cc) + *(const RLAS f32x4*)(cg + D_MODEL + cc); } }
        unsigned long long m = __builtin_amdgcn_ballot_w64(myslot >= 0);
#pragma unroll
        for (int q = 0; q < 2; ++q) { if (m) { m &= m - 1;
#pragma unroll
            for (int j = 0; j < 4; ++j) { const u32x2 w2 = yv[q][j]; moe[j][0] += blo(w2.x); moe[j][1] += bhi(w2.x); moe[j][2] += blo(w2.y); moe[j][3] += bhi(w2.y); } } }
        while (m) { const int e = __builtin_ctzll(m); m &= m - 1; const int s = shi_idx(myslot, e); const bf16_t* ys = YS + (size_t)s * D_MODEL;
#pragma unroll
            for (int j = 0; j < 4; ++j) { const u32x2 w2 = *(const u32x2*)(ys + 4 * lane + 256 * j); moe[j][0] += blo(w2.x); moe[j][1] += bhi(w2.x); moe[j][2] += blo(w2.y); moe[j][3] += bhi(w2.y); } }
#pragma unroll
        for (int j = 0; j < 4; ++j) v[j] = alpha * v[j] + *(const RLAS f32x4*)(cm + D_MODEL + 4 * lane + 256 * j) * moe[j];
        float mean, rstd; ln_stats(v, mean, rstd, lane);
#pragma unroll
        for (int j = 0; j < 4; ++j) { const int cc = 4 * lane + 256 * j; v[j] = (v[j] - mean) * rstd * *(const RLAS f32x4*)(cg + 2 * D_MODEL + cc) + *(const RLAS f32x4*)(cg + 3 * D_MODEL + cc); }
        if (l == DEPTH - 1) {
#pragma unroll
            for (int j = 0; j < 4; ++j) *(f32x4*)(out + (size_t)r * D_MODEL + 4 * lane + 256 * j) = v[j];
            continue; }
#pragma unroll
        for (int j = 0; j < 4; ++j) __builtin_nontemporal_store(v[j], (f32x4*)(xr + 4 * lane + 256 * j));
        ln_stats(v, mean, rstd, lane);
#pragma unroll
        for (int j = 0; j < 4; ++j) { const int cc = 4 * lane + 256 * j; const f32x4 y = (v[j] - mean) * rstd * (*(const RLAS f32x4*)(cm + 3 * D_MODEL + cc) + 1.0f) + *(const RLAS f32x4*)(cm + 2 * D_MODEL + cc);
            u32x2 o; o.x = pk(y[0], y[1]); o.y = pk(y[2], y[3]); *(u32x2*)(H + (size_t)r * D_MODEL + cc) = o; } }
    __syncthreads();
#undef LN2_LDY
}
#undef RLAS
}

#define XB_TMO      128
#define XB_XCNT(j)  (256  + 64 * (j))
#define XB_XSUB(j)  (1280 + 64 * (j))
#define XB_XGEN(j)  (2304 + 64 * (j))
#define XB_TOP      3328
#define XB_TOPGEN   3392
#define XCD_BAR_WORDS 3456
#define XB_SPIN_CAP (1u << 18)
#define LAS __attribute__((address_space(3)))
__device__ __forceinline__ unsigned xb_ld(unsigned* p)              { return __hip_atomic_load(p, __ATOMIC_RELAXED, __HIP_MEMORY_SCOPE_AGENT); }
__device__ __forceinline__ unsigned xb_add(unsigned* p, unsigned v) { return __hip_atomic_fetch_add(p, v, __ATOMIC_RELAXED, __HIP_MEMORY_SCOPE_AGENT); }
__device__ __forceinline__ unsigned xb_xcc_id() { return (unsigned)__builtin_amdgcn_s_getreg((3 << 11) | 20) & 0xFu; }
#define XB_SPIN(cond, bar) do { unsigned _sp = 0; while (cond) { __builtin_amdgcn_s_sleep(1); \
    if ((++_sp & 255u) == 0u) { if (xb_ld(&(bar)[XB_TMO])) break; if (_sp > XB_SPIN_CAP) { atomicAdd(&(bar)[XB_TMO], 1u); break; } } } } while (0)
struct XcdBarrier { unsigned* bar; unsigned x; volatile LAS unsigned* st; };
__device__ __forceinline__ XcdBarrier xcd_barrier_post(unsigned* bar, volatile LAS unsigned* st) {
    XcdBarrier b; b.bar = bar; b.x = xb_xcc_id(); b.st = st;
    if (ktid() == 0) (void)xb_add(&bar[XB_XCNT(b.x)], 1u);
    return b;
}
__device__ __forceinline__ void xcd_barrier_complete(unsigned* bar, unsigned x, unsigned& nloc, unsigned& nx) {
    const unsigned G = gridDim.x * gridDim.y * gridDim.z;
    unsigned sum, cnt, mine, sp = 0u;
    for (;;) {
        sum = 0u; cnt = 0u; mine = 0u;
#pragma unroll
        for (unsigned j = 0; j < 16; ++j) { const unsigned c = xb_ld(&bar[XB_XCNT(j)]); sum += c; cnt += (c > 0u) ? 1u : 0u; mine = (j == x) ? c : mine; }
        if (sum == G) break;
        __builtin_amdgcn_s_sleep(1);
        if ((++sp & 255u) == 0u) { if (xb_ld(&bar[XB_TMO])) break; if (sp > XB_SPIN_CAP) { atomicAdd(&bar[XB_TMO], 1u); break; } }
    }
    nloc = mine > 0u ? mine : 1u; nx = cnt > 0u ? cnt : 1u;
}
__device__ __forceinline__ void xcd_barrier(const XcdBarrier& b) {
    asm volatile("s_waitcnt vmcnt(0)" ::: "memory");
    __syncthreads();
    if (ktid() == 0) {
        unsigned* bar = b.bar;
        __builtin_amdgcn_s_waitcnt(0);
        unsigned nloc = b.st[0], nx = b.st[1];
        if (nloc == 0u) { xcd_barrier_complete(bar, b.x, nloc, nx); b.st[0] = nloc; b.st[1] = nx; }
        const unsigned old = xb_add(&bar[XB_XSUB(b.x)], 1u);
        const unsigned gen = old / nloc;
        if (old + 1u == (gen + 1u) * nloc) {
            __builtin_amdgcn_fence(__ATOMIC_RELEASE, "agent");
            asm volatile("s_waitcnt vmcnt(0)" ::: "memory");
            const unsigned og = xb_add(&bar[XB_TOP], 1u);
            const unsigned tg = og / nx;
            if (og + 1u == (tg + 1u) * nx) xb_add(&bar[XB_TOPGEN], 1u);
            else XB_SPIN(xb_ld(&bar[XB_TOPGEN]) == tg, bar);
            __builtin_amdgcn_fence(__ATOMIC_ACQUIRE, "agent");
            xb_add(&bar[XB_XGEN(b.x)], 1u);
            asm volatile("s_waitcnt vmcnt(0)" ::: "memory");
        } else {
            XB_SPIN(xb_ld(&bar[XB_XGEN(b.x)]) == gen, bar);
            __builtin_amdgcn_fence(__ATOMIC_ACQUIRE, "agent");
            asm volatile("s_waitcnt vmcnt(0)" ::: "memory");
        }
    }
    __syncthreads();
}

constexpr int NWAVES = 8, NTHREADS = NWAVES * 64;
constexpr int RING_BYTES = 131072, MISC_OFF = RING_BYTES, LDS_BYTES = 147456;
constexpr int CW_Q = 2048;
constexpr int CW_BAR = 8192, BAR_STRIDE = 4096;
enum { PH_GEMM_IN = 0, PH_PREP, PH_INTRA, PH_MIX, PH_GDN_FIN, PH_BRANCH, PH_OUT, PH_LN1, PH_TOPK, PH_MOE1, PH_MOE2, PH_LN2, PPL };
constexpr int N_PHASES = 2 + DEPTH * PPL, FIN_ROWS = 64;
static_assert(NLAT % FIN_ROWS == 0 && NTOK % FIN_ROWS == 0, "GDN_FIN units");

#ifndef PROBE_REPEAT
#define PROBE_REPEAT 0u
#endif
__global__ void __launch_bounds__(NTHREADS, 2) mega_fwd(KArgs ka) {
    extern __shared__ __attribute__((aligned(16))) unsigned char lds[];
    PG8_LAS unsigned char* ring = (PG8_LAS unsigned char*)lds;
    volatile LAS unsigned* misc = (volatile LAS unsigned*)((LAS unsigned char*)lds + MISC_OFF);
    if (threadIdx.x < 64) misc[threadIdx.x] = 0u;
    if ((threadIdx.x & 63) == 0) ((volatile LAS int*)((LAS unsigned char*)lds + KTID_TAB_OFF))[(unsigned)__builtin_amdgcn_s_getreg((5 << 11) | 4) & 63u] = (int)(threadIdx.x >> 6);
    __syncthreads();
    XcdBarrier bar = xcd_barrier_post((unsigned*)ws_at(ka.ws, WSO.CTL) + CW_BAR + ka.pad * BAR_STRIDE, misc);
    const int lo = ka.i1, hi = ka.i2, G = (int)gridDim.x, c = (int)blockIdx.x;
    const float alpha = deepnorm_alpha();
#define PHASE_WS() size_t wso_ = 0; asm volatile("" : "+s"(wso_)); unsigned char* wsb_ = ka.ws + wso_
#define WSP(name, type) ((type*)ws_at(wsb_, WSO.name))
#define IN(p) (lo <= (p) && (p) < hi)
#define SEAM(p) do { if (IN(p) && IN((p) + 1)) xcd_barrier(bar); } while (0)
    if (IN(0)) { PHASE_WS(); rowp::prologue_a(wsb_, ka.in, (char*)lds, G, c); }
    SEAM(0);
    if (IN(1)) { PHASE_WS(); rowp::prologue_b(wsb_, ka.in, (char*)lds, G, c); }
    SEAM(1);
    for (int l = 0; l < DEPTH; ++l) {
        const int pb = 2 + l * PPL; const bool lastl = l == DEPTH - 1;
        for (int rep_ = 0; rep_ <= (int)((PROBE_REPEAT >> PH_GEMM_IN) & 1u); ++rep_) { if (rep_) xcd_barrier(bar); if (IN(pb + PH_GEMM_IN)) { PHASE_WS(); const SchedIn S{WSP(H, bf16_t), WSP(WinT, bf16_t) + (size_t)l * ZN * D_MODEL, G, c}; const EpiZ E{WSP(Z, bf16_t), WSP(GT, bf16_t), WSP(XS, bf16_t)}; pg8::gemm_phase(ring, D_MODEL, S, E); } }
        SEAM(pb + PH_GEMM_IN);
        for (int rep_ = 0; rep_ <= (int)((PROBE_REPEAT >> PH_PREP) & 1u); ++rep_) { if (rep_) xcd_barrier(bar); if (IN(pb + PH_PREP)) { PHASE_WS(); rowp::prep_phase(wsb_, ka.in, l, (char*)lds, G, c); } }
        SEAM(pb + PH_PREP);
        for (int rep_ = 0; rep_ <= (int)((PROBE_REPEAT >> PH_INTRA) & 1u); ++rep_) { if (rep_) xcd_barrier(bar); if (IN(pb + PH_INTRA)) { PHASE_WS(); gdn::intra_phase(wsb_, (char*)lds, G, c); } }
        SEAM(pb + PH_INTRA);
        for (int rep_ = 0; rep_ <= (int)((PROBE_REPEAT >> PH_MIX) & 1u); ++rep_) { if (rep_) xcd_barrier(bar); if (IN(pb + PH_MIX)) { PHASE_WS(); if (c < gdn::NCHAIN) { gdn::scan_chain(wsb_, c, (char*)lds);
            if (ktid() == 0) { __builtin_amdgcn_fence(__ATOMIC_RELEASE, "agent"); asm volatile("s_waitcnt vmcnt(0)" ::: "memory"); (void)xb_add(WSP(CTL, unsigned) + CW_Q + 128 * (28 + l), 1u); } } } }
        for (int rep_ = 0; rep_ <= (int)((PROBE_REPEAT >> PH_MIX) & 1u); ++rep_) { if (rep_) xcd_barrier(bar); if (IN(pb + PH_MIX)) { PHASE_WS(); attn_phase_dense(wsb_, WSP(CTL, unsigned) + CW_Q + 128 * (2 * l + rep_ * 16), lastl ? ATT_NBIG : ATT_NBIG + ATT_NSMALL, (char*)lds, G, c); attn_phase_na(wsb_, ka.in[8] + (size_t)l * B_HEADS * NA_TAB_N, WSP(CTL, unsigned) + CW_Q + 128 * (2 * l + 1 + rep_ * 16), (char*)lds, G, c); } }
        if (IN(pb + PH_MIX)) { { PHASE_WS();
            { unsigned* qf = WSP(CTL, unsigned) + CW_Q + 128 * (24 + l); unsigned* done = WSP(CTL, unsigned) + CW_Q + 128 * (28 + l);
              const int nrows_f = lastl ? NLAT : NTOK, nfin = nrows_f / FIN_ROWS; bool ready = false;
              for (;;) { const int u = claim_unit(qf, (char*)lds); if (u >= nfin) break;
                  if (!ready) { if (ktid() == 0) { unsigned sp_ = 0; while (xb_ld(done) < (unsigned)gdn::NCHAIN && ++sp_ < (1u << 24)) __builtin_amdgcn_s_sleep(2);
                                                   __builtin_amdgcn_fence(__ATOMIC_ACQUIRE, "agent"); asm volatile("s_waitcnt vmcnt(0)" ::: "memory"); }
                                __syncthreads(); ready = true; }
                  rowp::gdn_fin_rows(wsb_, ka.in, l, u * FIN_ROWS, 8, (u + 1) * FIN_ROWS); } } } }
        SEAM(pb + PH_MIX);
        for (int rep_ = 0; rep_ <= (int)((PROBE_REPEAT >> PH_BRANCH) & 1u); ++rep_) { if (rep_) xcd_barrier(bar); if (IN(pb + PH_BRANCH)) { PHASE_WS(); const SchedBranch S{WSP(OA, bf16_t), WSP(WbrT, bf16_t) + (size_t)l * N_BRANCH * D_MODEL * BRANCH_W, G, c, (lastl ? NLAT : NTOK) / BM}; const EpiBranch E{WSP(GT, bf16_t), WSP(MB, bf16_t)}; pg8::gemm_phase(ring, BRANCH_W, S, E);
            if (!lastl && c >= (NTOK / BM * (D_MODEL / BM)) % G) rowp::convert_queue(wsb_, ka.in, WSP(CTL, unsigned) + CW_Q + 128 * (44 + l), l + 1, 10, (char*)lds); } }
        SEAM(pb + PH_BRANCH);
        for (int rep_ = 0; rep_ <= (int)((PROBE_REPEAT >> PH_OUT) & 1u); ++rep_) { if (rep_) xcd_barrier(bar); if (IN(pb + PH_OUT)) { PHASE_WS(); const SchedOut S{WSP(MB, bf16_t), WSP(WoutT, bf16_t) + (size_t)l * D_MODEL * D_MODEL, G, c, (lastl ? NLAT : NTOK) / BM}; const EpiOut E{WSP(OA, bf16_t)};     pg8::gemm_phase(ring, D_MODEL, S, E);
            if (!lastl && c >= (NTOK / BM * (D_MODEL / BM)) % G) rowp::convert_queue(wsb_, ka.in, WSP(CTL, unsigned) + CW_Q + 128 * (44 + l), l + 1, 5, (char*)lds); } }
        SEAM(pb + PH_OUT);
        for (int rep_ = 0; rep_ <= (int)((PROBE_REPEAT >> PH_LN1) & 1u); ++rep_) { if (rep_) xcd_barrier(bar); if (IN(pb + PH_LN1)) { PHASE_WS(); rowp::ln1_phase(wsb_, ka.in, l, alpha, lastl ? NLAT : NTOK, (char*)lds, G, c); } }
        SEAM(pb + PH_LN1);
        for (int rep_ = 0; rep_ <= (int)((PROBE_REPEAT >> PH_TOPK) & 1u); ++rep_) { if (rep_) xcd_barrier(bar); if (IN(pb + PH_TOPK)) { PHASE_WS(); rowp::topk_phase(wsb_, (lastl ? 1 : 2) * BATCH * N_EXPERTS, (char*)lds, G, c); } }
        SEAM(pb + PH_TOPK);
        for (int rep_ = 0; rep_ <= (int)((PROBE_REPEAT >> PH_MOE1) & 1u); ++rep_) { if (rep_) xcd_barrier(bar); if (IN(pb + PH_MOE1)) { PHASE_WS(); const SchedMoe1 S{WSP(H, bf16_t), WSP(TOKLIST, int), WSP(WguT, bf16_t) + (size_t)l * N_EXPERTS * 2 * D_EXPERT * D_MODEL, G, c, (lastl ? NSLOT_L : NSLOT) / BM}; const EpiGU E{WSP(ACT, bf16_t)}; pg8::gemm_phase<EpiGU, SchedMoe1, true, true, true>(ring, D_MODEL, S, E); } }
        SEAM(pb + PH_MOE1);
        for (int rep_ = 0; rep_ <= (int)((PROBE_REPEAT >> PH_MOE2) & 1u); ++rep_) { if (rep_) xcd_barrier(bar); if (IN(pb + PH_MOE2)) { PHASE_WS(); const SchedMoe2 S{WSP(ACT, bf16_t), WSP(WdnT, bf16_t) + (size_t)l * N_EXPERTS * D_MODEL * D_EXPERT, G, c, (lastl ? NSLOT_L : NSLOT) / BM}; const EpiDown E{WSP(GATEV, float), WSP(YS, bf16_t)}; pg8::gemm_phase(ring, D_EXPERT, S, E);
            if (!lastl && c >= (NSLOT / BM * (D_MODEL / BM)) % G) rowp::convert_queue(wsb_, ka.in, WSP(CTL, unsigned) + CW_Q + 128 * (44 + l), l + 1, 5, (char*)lds); } }
        SEAM(pb + PH_MOE2);
        for (int rep_ = 0; rep_ <= (int)((PROBE_REPEAT >> PH_LN2) & 1u); ++rep_) { if (rep_) xcd_barrier(bar); if (IN(pb + PH_LN2)) { PHASE_WS(); rowp::ln2_phase(wsb_, ka.in, ka.out, l, alpha, (char*)lds, G, c);
            if (!lastl) rowp::convert_queue(wsb_, ka.in, WSP(CTL, unsigned) + CW_Q + 128 * (44 + l), l + 1, -1, (char*)lds); } }
        SEAM(pb + PH_LN2);
    }
#undef IN
#undef SEAM
}

#ifndef MK_CUTS
#define MK_CUTS 0
#endif
extern "C" void kernel_launch(void* const* d_in, const int* in_sizes, int n_in, void* d_out, int out_size, void* d_ws, size_t ws_size, hipStream_t stream) {
    static int grid = 0;
    if (grid == 0) {
        int dev = 0, cus = 0, per_cu = 0;
        if (hipGetDevice(&dev) != hipSuccess || hipDeviceGetAttribute(&cus, hipDeviceAttributeMultiprocessorCount, dev) != hipSuccess) { fprintf(stderr, "kernel_launch: device query failed\n"); grid = -1; return; }
        if (hipFuncSetAttribute((const void*)mega_fwd, hipFuncAttributeMaxDynamicSharedMemorySize, LDS_BYTES) != hipSuccess) { fprintf(stderr, "kernel_launch: hipFuncSetAttribute failed\n"); grid = -1; return; }
        if (hipOccupancyMaxActiveBlocksPerMultiprocessor(&per_cu, (const void*)mega_fwd, NTHREADS, LDS_BYTES) != hipSuccess || per_cu < 1) fprintf(stderr, "kernel_launch: occupancy query reports %d\n", per_cu);
        (void)hipGetLastError();
        grid = cus;
    }
    if (grid < 0) return;
    KArgs ka; memset(&ka, 0, sizeof ka);
    for (int i = 0; i < 22; ++i) ka.in[i] = (const float*)d_in[i];
    const size_t need = WSO.total; ka.ws = (unsigned char*)d_ws;
    if (need > ws_size) { fprintf(stderr, "workspace too small: need %zu have %zu\n", need, ws_size); return; }
    ka.out = (float*)d_out;
    (void)hipMemsetAsync(ka.ws + WSO.CTL, 0, 1 << 20, stream);
    int n_mega = 0;
    auto mega = [&](int lo, int hi) { KArgs a = ka; a.i1 = lo; a.i2 = hi; a.pad = n_mega++; hipLaunchKernelGGL(mega_fwd, dim3(grid), dim3(NTHREADS), LDS_BYTES, stream, a); };
    if (MK_CUTS == 0) mega(0, N_PHASES);
    else for (int p = 0; p < N_PHASES; p += MK_CUTS) mega(p, p + MK_CUTS < N_PHASES ? p + MK_CUTS : N_PHASES);
    const hipError_t le = hipPeekAtLastError();
    if (le != hipSuccess) fprintf(stderr, "kernel_launch: launch failed: %s\n", hipGetErrorName(le));
}
#endif

#ifdef HOST_TEST
#include <vector>
#include <cstdlib>
#define RUN(k) k(ka, ka.l, ka.i1, ka.i2)
int main(int argc, char** argv) {
    const char* dir = argc > 1 ? argv[1] : ".";
    const size_t sizes[22] = {(size_t)NLAT * D_MODEL, (size_t)BATCH * D_MODEL, (size_t)NCTX * D_MODEL, (size_t)D_MODEL, (size_t)DEPTH * D_MODEL * N_MOD * D_MODEL, (size_t)DEPTH * N_MOD * D_MODEL,
        (size_t)DEPTH * D_MODEL * D_IN, (size_t)DEPTH * 2 * HD, (size_t)DEPTH * B_HEADS * (2 * NA_ROWS - 1) * (2 * NA_COLS - 1), (size_t)DEPTH * CONV_K * 3 * C_W, (size_t)DEPTH * 2 * C_HEADS, (size_t)DEPTH * 2 * C_HEADS,
        (size_t)DEPTH * HD, (size_t)DEPTH * N_BRANCH * BRANCH_W * D_MODEL, (size_t)DEPTH * D_MODEL * D_MODEL, (size_t)DEPTH * D_MODEL, (size_t)DEPTH * D_MODEL, (size_t)DEPTH * D_MODEL * N_EXPERTS,
        (size_t)DEPTH * N_EXPERTS * D_MODEL * 2 * D_EXPERT, (size_t)DEPTH * N_EXPERTS * D_EXPERT * D_MODEL, (size_t)DEPTH * D_MODEL, (size_t)DEPTH * D_MODEL};
    std::vector<std::vector<float>> bufs(22); char path[512]; snprintf(path, sizeof path, "%s/inputs.bin", dir);
    FILE* f = fopen(path, "rb"); if (!f) { perror(path); return 1; }
    for (int i = 0; i < 22; ++i) { bufs[i].resize(sizes[i]); if (fread(bufs[i].data(), 4, sizes[i], f) != sizes[i]) { fprintf(stderr, "short read input %d\n", i); return 1; } }
    fclose(f);
    const float* p[22]; for (int i = 0; i < 22; ++i) p[i] = bufs[i].data();
    Inputs in{p[0], p[1], p[2], p[3], p[4], p[5], p[6], p[7], p[8], p[9], p[10], p[11], p[12], p[13], p[14], p[15], p[16], p[17], p[18], p[19], p[20], p[21]};
    std::vector<unsigned char> wsbuf(WSO.total, 0xAA); WS w = make_ws(wsbuf.data());
    std::vector<float> out((size_t)NLAT * D_MODEL);
    KArgs ka; memset(&ka, 0, sizeof ka); for (int i = 0; i < 22; ++i) ka.in[i] = p[i]; ka.ws = wsbuf.data(); ka.out = out.data();
    RUN(p_prep_weights); RUN(p_mod_init); ka.l = 0; ka.i1 = 0; ka.i2 = 1; RUN(p_ln_mod);
    auto cmp = [&](const char* name, auto get, size_t n) { snprintf(path, sizeof path, "%s/dbg_%s.bin", dir, name); FILE* g = fopen(path, "rb"); if (!g) return; std::vector<float> ref(n); size_t got = fread(ref.data(), 4, n, g); fclose(g);
        if (got != n) { printf("  %s: size mismatch %zu vs %zu\n", name, got, n); return; } double se = 0, sr = 0, mx = 0; for (size_t i = 0; i < n; ++i) { const double d = (double)get(i) - ref[i]; se += d * d; sr += (double)ref[i] * ref[i]; if (fabs(d) > mx) mx = fabs(d); }
        printf("  %-8s rvr=%.3e absmax=%.3e (ref rms %.3e)\n", name, se / sr, mx, sqrt(sr / n)); };
    for (int l = 0; l < DEPTH; ++l) {
        ka.l = l; RUN(p_gemm_in_naive); RUN(p_prep_a); RUN(p_prep_c);
        RUN(p_attn_a_naive); RUN(p_attn_b_naive); RUN(p_gdn_naive); RUN(p_gdn_fin);
        if (l == 0) { cmp("o_a", [&](size_t i) { return bf2f(w.OA[i]); }, (size_t)NLAT * BRANCH_W); cmp("o_b", [&](size_t i) { return bf2f(w.OB[i]); }, (size_t)NLAT * BRANCH_W); cmp("o_c", [&](size_t i) { return bf2f(w.OC[i]); }, (size_t)NLAT * BRANCH_W);
            cmp("o_a_x", [&](size_t i) { return bf2f(w.OA[(size_t)NLAT * BRANCH_W + i]); }, (size_t)NCTX * BRANCH_W); cmp("o_b_x", [&](size_t i) { return bf2f(w.OB[(size_t)NLAT * BRANCH_W + i]); }, (size_t)NCTX * BRANCH_W);
            cmp("o_c_x", [&](size_t i) { return bf2f(w.OC[(size_t)NLAT * BRANCH_W + i]); }, (size_t)NCTX * BRANCH_W); }
        RUN(p_branch_naive); RUN(p_out_naive); RUN(p_ln1_router);
        if (l == 0) cmp("x1", [&](size_t i) { return w.X[i]; }, (size_t)NLAT * D_MODEL);
        RUN(p_topk_naive); RUN(p_moe1_naive); RUN(p_moe2_naive); RUN(p_ln2);
        if (l == 0) { cmp("x2", [&](size_t i) { return w.X[i]; }, (size_t)NLAT * D_MODEL); cmp("ctx2", [&](size_t i) { return w.X[(size_t)NLAT * D_MODEL + i]; }, (size_t)NCTX * D_MODEL); }
    }
    snprintf(path, sizeof path, "%s/ref_out.bin", dir); f = fopen(path, "rb"); std::vector<float> ref(out.size()); if (fread(ref.data(), 4, ref.size(), f) != ref.size()) return 1; fclose(f);
    double se = 0, sr = 0, mx = 0; for (size_t i = 0; i < out.size(); ++i) { const double d = (double)out[i] - ref[i]; se += d * d; sr += (double)ref[i] * ref[i]; if (fabs(d) > mx) mx = fabs(d); }
    printf("FINAL rvr=%.3e absmax=%.3e\n", se / sr, mx);
    return 0;
}
#endif
```
